# Optimizing an MI355X kernel written in HIP

```python
import math, functools
import jax, jax.numpy as jnp
from jax import lax
import numpy as np

D_MODEL = 1024
BATCH = 4
SEQ = 4096
DEPTH = 2
DEC_BATCH = 128
DEC_SEQ = 4
PAST_LEN = 2048
PAGE_SIZE = 128

MIX_W = D_MODEL
A_W = MIX_W // 2
B_W = MIX_W // 2
C_W = MIX_W // 2
ATT_W = MIX_W // 2
CHUNK = 128
A_GROUPS = A_W // CHUNK
A_GROUP_W = A_W // A_GROUPS
CONV_W = 3
POOL_WINDOWS = (2, 4, 8, 16)
C_GROUPS = len(POOL_WINDOWS)
C_GROUP_W = C_W // C_GROUPS
POOL_HIST = max(POOL_WINDOWS) - 1
HEAD_DIM = 64
N_HEADS = ATT_W // HEAD_DIM
IDX_HEADS = 8
IDX_DIM = 64
TOPK_MAX = 256
Q_BLOCK = 128
ROPE_THETA = 500000.0
D_FF = ((8 * D_MODEL // 3 + 127) // 128) * 128
N_EVEN = (DEPTH + 1) // 2
N_ODD = DEPTH // 2
ALPHA = (2.0 * DEPTH) ** 0.25
BETA = (8.0 * DEPTH) ** -0.25
LN_EPS = 1e-5
ATT_SCALE = HEAD_DIM ** -0.5

E_U = 0
E_V = E_U + A_W
E_B = E_V + A_W
E_C = E_B + B_W
E_H = E_C + B_W
EVEN_COLS = E_H + B_W
O_P = 0
O_Q = O_P + C_W
O_K = O_Q + ATT_W
O_V = O_K + ATT_W
O_QI = O_V + ATT_W
O_KI = O_QI + IDX_HEADS * IDX_DIM
O_WI = O_KI + IDX_DIM
ODD_COLS = O_WI + IDX_HEADS

kernel_name = 'hybrid_gmlp_conv_pool_dsa_step'


def layer_norm(x, g, b):
    xf = x.astype(jnp.float32)
    mu = jnp.mean(xf, axis=-1, keepdims=True)
    var = jnp.mean(jnp.square(xf - mu), axis=-1, keepdims=True)
    y = (xf - mu) * lax.rsqrt(var + LN_EPS)
    return (y * g.astype(jnp.float32) + b.astype(jnp.float32)).astype(x.dtype)


def causal_dwconv(ext, w):
    t = ext.shape[1] - (CONV_W - 1)
    out = ext[:, CONV_W - 1:] * w[CONV_W - 1]
    for j in range(CONV_W - 1):
        out = out + ext[:, j:j + t] * w[j]
    return out


def partial_rope(x, pos):
    d = x.shape[-1]
    rot = d // 4
    half = rot // 2
    inv = jnp.power(jnp.float32(ROPE_THETA), -jnp.arange(half, dtype=jnp.float32) * 2.0 / rot)
    ang = pos.astype(jnp.float32)[:, None] * inv[None, :]
    cos = jnp.cos(ang)[None, :, None, :]
    sin = jnp.sin(ang)[None, :, None, :]
    x1 = x[..., :half].astype(jnp.float32)
    x2 = x[..., half:rot].astype(jnp.float32)
    r1 = (x1 * cos - x2 * sin).astype(x.dtype)
    r2 = (x2 * cos + x1 * sin).astype(x.dtype)
    return jnp.concatenate([r1, r2, x[..., rot:]], axis=-1)


def chunk_spatial_gate(u, v, w_s, b_s):
    n, t, _ = v.shape
    n_ch = -(-t // CHUNK)
    pad = n_ch * CHUNK - t
    vp = jnp.pad(v, ((0, 0), (0, pad), (0, 0))).reshape(n, n_ch, CHUNK, A_GROUPS, A_GROUP_W)
    mask = jnp.tril(jnp.ones((CHUNK, CHUNK), dtype=bool))
    w_c = jnp.where(mask[None], w_s, jnp.zeros_like(w_s))
    mix = jnp.einsum('gts,bnsgc->bntgc', w_c, vp) + b_s.T[:, :, None]
    mix = mix.reshape(n, n_ch * CHUNK, A_W)[:, :t]
    return u * mix


def multiscale_pool(ext, pos):
    t = pos.shape[0]
    csum = jnp.cumsum(ext.astype(jnp.float32), axis=1)
    cs = jnp.concatenate([jnp.zeros_like(csum[:, :1]), csum], axis=1)
    end = cs[:, POOL_HIST + 1:]
    outs = []
    for g, w in enumerate(POOL_WINDOWS):
        sl = slice(g * C_GROUP_W, (g + 1) * C_GROUP_W)
        start = cs[:, POOL_HIST + 1 - w:POOL_HIST + 1 - w + t, sl]
        cnt = jnp.minimum(w, pos + 1).astype(jnp.float32)[None, :, None]
        outs.append((end[..., sl] - start) / cnt)
    mean = jnp.concatenate(outs, axis=-1)
    return (mean - ext[:, POOL_HIST:].astype(jnp.float32)).astype(ext.dtype)


def index_select(qi, wi, ki_all, pos_q, k_sel):
    dots = jax.nn.relu(jnp.einsum('nthd,nsd->nths', qi, ki_all))
    score = jnp.einsum('nth,nths->nts', wi, dots).astype(jnp.float32)
    admissible = jnp.arange(ki_all.shape[1])[None, :] <= pos_q[:, None]
    score = jnp.where(admissible[None], score, -jnp.inf)
    _, idx = lax.top_k(score, k_sel)
    return idx


def sparse_attend(q, ks, vs, idx, pos_q):
    logits = jnp.einsum('nthd,ntkhd->nthk', q, ks).astype(jnp.float32) * ATT_SCALE
    valid = (idx <= pos_q[None, :, None])[:, :, None, :]
    p = jax.nn.softmax(jnp.where(valid, logits, -jnp.inf), axis=-1).astype(q.dtype)
    return jnp.einsum('nthk,ntkhd->nthd', p, vs)


def dsa_prompt(q, k, v, qi, ki, wi):
    n, s = q.shape[:2]
    k_sel = min(TOPK_MAX, s // 4)
    nb = s // Q_BLOCK
    nidx = jnp.arange(n)[:, None, None]

    def block(args):
        qb, qib, wib, start = args
        pos_q = start + jnp.arange(Q_BLOCK, dtype=jnp.int32)
        idx = index_select(qib, wib, ki, pos_q, k_sel)
        return sparse_attend(qb, k[nidx, idx], v[nidx, idx], idx, pos_q)

    to_blocks = lambda a: a.reshape(n, nb, Q_BLOCK, *a.shape[2:]).swapaxes(0, 1)
    starts = jnp.arange(nb, dtype=jnp.int32) * Q_BLOCK
    out = lax.map(block, (to_blocks(q), to_blocks(qi), to_blocks(wi), starts))
    return out.swapaxes(0, 1).reshape(n, s, N_HEADS, HEAD_DIM)


def dsa_sample(q, k, v, qi, ki, wi, *, layer, cache_k, cache_v, cache_kidx, page_table):
    n, t = q.shape[:2]
    past_len = page_table.shape[1] * PAGE_SIZE
    k_sel = min(TOPK_MAX, (past_len + t) // 4)
    ki_past = cache_kidx[layer, page_table].reshape(n, past_len, IDX_DIM)
    ki_all = jnp.concatenate([ki_past, ki], axis=1)
    pos_q = past_len + jnp.arange(t, dtype=jnp.int32)
    idx = index_select(qi, wi, ki_all, pos_q, k_sel)
    nidx = jnp.arange(n)[:, None, None]
    in_past = (idx < past_len)[..., None, None]
    pidx = jnp.minimum(idx, past_len - 1)
    phys = page_table[nidx, pidx // PAGE_SIZE]
    off = pidx % PAGE_SIZE
    nnew = jnp.clip(idx - past_len, 0, t - 1)
    ks = jnp.where(in_past, cache_k[layer, phys, off], k[nidx, nnew])
    vs = jnp.where(in_past, cache_v[layer, phys, off], v[nidx, nnew])
    return sparse_attend(q, ks, vs, idx, pos_q)


def even_mixer(x, conv_hist, w_in, a_ln_g, a_ln_b, a_ws, a_bs, b_conv_w, w_out):
    h = x @ w_in
    u = jax.nn.gelu(h[..., E_U:E_V])
    v = layer_norm(jax.nn.gelu(h[..., E_V:E_B]), a_ln_g, a_ln_b)
    a_out = chunk_spatial_gate(u, v, a_ws, a_bs)
    ext = jnp.concatenate([conv_hist, h[..., E_C:E_H] * h[..., E_H:EVEN_COLS]], axis=1)
    b_out = h[..., E_B:E_C] * causal_dwconv(ext, b_conv_w)
    y = jnp.concatenate([a_out, b_out], axis=-1) @ w_out
    return y, v, ext[:, -(CONV_W - 1):]


def odd_mixer(x, pool_hist, pos, attn_fn, w_in, c_w, c_scale, w_out):
    n, t, _ = x.shape
    h = x @ w_in
    q = partial_rope(h[..., O_Q:O_K].reshape(n, t, N_HEADS, HEAD_DIM), pos)
    k = partial_rope(h[..., O_K:O_V].reshape(n, t, N_HEADS, HEAD_DIM), pos)
    v = h[..., O_V:O_QI].reshape(n, t, N_HEADS, HEAD_DIM)
    qi = partial_rope(h[..., O_QI:O_KI].reshape(n, t, IDX_HEADS, IDX_DIM), pos)
    ki = partial_rope(h[..., O_KI:O_WI][:, :, None, :], pos)[:, :, 0]
    wi = h[..., O_WI:ODD_COLS]
    ext = jnp.concatenate([pool_hist, h[..., O_P:O_Q]], axis=1)
    pooled = multiscale_pool(ext, pos).reshape(n, t, C_GROUPS, C_GROUP_W)
    c_out = jnp.einsum('ntgc,gcd->ntgd', pooled, c_w).reshape(n, t, C_W) * c_scale
    att = attn_fn(q, k, v, qi, ki, wi).reshape(n, t, ATT_W)
    y = jnp.concatenate([c_out, att], axis=-1) @ w_out
    return y, ext[:, -POOL_HIST:], k, v, ki


def conv_ffn(x, hist, w_up, conv_w, conv_b, w_down):
    hu = x @ w_up
    ext = jnp.concatenate([hist, hu], axis=1)
    hc = causal_dwconv(ext, conv_w) + conv_b
    y = (jax.nn.silu(hc[..., :D_FF]) * hc[..., D_FF:]) @ w_down
    return y, ext[:, -(CONV_W - 1):]


def setup_inputs(seed: int = 0) -> dict:
    key = jax.random.key(seed)
    ks = jax.random.split(key, 32)
    n_pages = PAST_LEN // PAGE_SIZE
    n_pool = (5 * DEC_BATCH * n_pages) // 4
    nrm = lambda k, shape, s=1.0: s * jax.random.normal(k, shape, jnp.float32)
    perm = jax.random.permutation(ks[0], n_pool)
    page_table = perm[:DEC_BATCH * n_pages].reshape(DEC_BATCH, n_pages).astype(jnp.int32)
    return {
        'x_prompt': nrm(ks[1], (BATCH, SEQ, D_MODEL)),
        'x_sample': nrm(ks[2], (DEC_BATCH, DEC_SEQ, D_MODEL)),
        'state_b_conv': nrm(ks[3], (N_EVEN, DEC_BATCH, CONV_W - 1, B_W)),
        'state_c_pool': nrm(ks[4], (N_ODD, DEC_BATCH, POOL_HIST, C_W)),
        'cache_k': nrm(ks[5], (N_ODD, n_pool, PAGE_SIZE, N_HEADS, HEAD_DIM)),
        'cache_v': nrm(ks[6], (N_ODD, n_pool, PAGE_SIZE, N_HEADS, HEAD_DIM)),
        'cache_kidx': nrm(ks[7], (N_ODD, n_pool, PAGE_SIZE, IDX_DIM)),
        'state_ffn_conv': nrm(ks[8], (DEPTH, DEC_BATCH, CONV_W - 1, 2 * D_FF)),
        'page_table': page_table,
        'w_in_even': nrm(ks[9], (N_EVEN, D_MODEL, EVEN_COLS), D_MODEL ** -0.5),
        'a_ln_g': 1.0 + nrm(ks[10], (N_EVEN, A_W), 0.1),
        'a_ln_b': nrm(ks[11], (N_EVEN, A_W), 0.1),
        'a_ws': nrm(ks[12], (N_EVEN, A_GROUPS, CHUNK, CHUNK), CHUNK ** -0.5),
        'a_bs': 1.0 + nrm(ks[13], (N_EVEN, A_GROUPS, CHUNK), 0.1),
        'b_conv_w': nrm(ks[14], (N_EVEN, CONV_W, B_W), CONV_W ** -0.5),
        'w_out_even': nrm(ks[15], (N_EVEN, A_W + B_W, D_MODEL), BETA * (A_W + B_W) ** -0.5),
        'w_in_odd': nrm(ks[16], (N_ODD, D_MODEL, ODD_COLS), D_MODEL ** -0.5),
        'c_w': nrm(ks[17], (N_ODD, C_GROUPS, C_GROUP_W, C_GROUP_W), C_GROUP_W ** -0.5),
        'c_scale': 1.0 + nrm(ks[18], (N_ODD, C_W), 0.1),
        'w_out_odd': nrm(ks[19], (N_ODD, C_W + ATT_W, D_MODEL), BETA * (C_W + ATT_W) ** -0.5),
        'ln_mix_g': 1.0 + nrm(ks[20], (DEPTH, D_MODEL), 0.1),
        'ln_mix_b': nrm(ks[21], (DEPTH, D_MODEL), 0.1),
        'ffn_w_up': nrm(ks[22], (DEPTH, D_MODEL, 2 * D_FF), D_MODEL ** -0.5),
        'ffn_conv_w': nrm(ks[23], (DEPTH, CONV_W, 2 * D_FF), CONV_W ** -0.5),
        'ffn_conv_b': nrm(ks[24], (DEPTH, 2 * D_FF), 0.02),
        'ffn_w_down': nrm(ks[25], (DEPTH, D_FF, D_MODEL), BETA * D_FF ** -0.5),
        'ln_ffn_g': 1.0 + nrm(ks[26], (DEPTH, D_MODEL), 0.1),
        'ln_ffn_b': nrm(ks[27], (DEPTH, D_MODEL), 0.1),
    }


def reference(x_prompt, x_sample, state_b_conv, state_c_pool, cache_k, cache_v, cache_kidx,
              state_ffn_conv, page_table, w_in_even, a_ln_g, a_ln_b, a_ws, a_bs, b_conv_w,
              w_out_even, w_in_odd, c_w, c_scale, w_out_odd, ln_mix_g, ln_mix_b, ffn_w_up,
              ffn_conv_w, ffn_conv_b, ffn_w_down, ln_ffn_g, ln_ffn_b):
    xp, xs = x_prompt, x_sample
    n_p, seq = xp.shape[:2]
    n_s, t_s = xs.shape[:2]
    pos_p = jnp.arange(seq, dtype=jnp.int32)
    pos_s = PAST_LEN + jnp.arange(t_s, dtype=jnp.int32)
    a_v_s, b_p, b_s, c_p, c_s = [], [], [], [], []
    k_p, v_p, ki_p, k_s, v_s, ki_s = [], [], [], [], [], []
    f_p, f_s = [], []
    for layer in range(DEPTH):
        if layer % 2 == 0:
            e = layer // 2
            wts = (w_in_even[e], a_ln_g[e], a_ln_b[e], a_ws[e], a_bs[e], b_conv_w[e], w_out_even[e])
            yp, _, bp = even_mixer(xp, jnp.zeros((n_p, CONV_W - 1, B_W), xp.dtype), *wts)
            ys, av, bs = even_mixer(xs, state_b_conv[e], *wts)
            a_v_s.append(av)
            b_p.append(bp)
            b_s.append(bs)
        else:
            o = layer // 2
            wts = (w_in_odd[o], c_w[o], c_scale[o], w_out_odd[o])
            yp, cp, kp, vp, kip = odd_mixer(xp, jnp.zeros((n_p, POOL_HIST, C_W), xp.dtype),
                                            pos_p, dsa_prompt, *wts)
            attn_s = functools.partial(dsa_sample, layer=o, cache_k=cache_k, cache_v=cache_v,
                                       cache_kidx=cache_kidx, page_table=page_table)
            ys, cs, kss, vss, kis = odd_mixer(xs, state_c_pool[o], pos_s, attn_s, *wts)
            c_p.append(cp)
            c_s.append(cs)
            k_p.append(kp)
            v_p.append(vp)
            ki_p.append(kip)
            k_s.append(kss)
            v_s.append(vss)
            ki_s.append(kis)
        xp = layer_norm(ALPHA * xp + yp, ln_mix_g[layer], ln_mix_b[layer])
        xs = layer_norm(ALPHA * xs + ys, ln_mix_g[layer], ln_mix_b[layer])
        fw = (ffn_w_up[layer], ffn_conv_w[layer], ffn_conv_b[layer], ffn_w_down[layer])
        fp, hp = conv_ffn(xp, jnp.zeros((n_p, CONV_W - 1, 2 * D_FF), xp.dtype), *fw)
        fs, hs = conv_ffn(xs, state_ffn_conv[layer], *fw)
        f_p.append(hp)
        f_s.append(hs)
        xp = layer_norm(ALPHA * xp + fp, ln_ffn_g[layer], ln_ffn_b[layer])
        xs = layer_norm(ALPHA * xs + fs, ln_ffn_g[layer], ln_ffn_b[layer])
    return (xp, xs, jnp.stack(a_v_s), jnp.stack(b_p), jnp.stack(b_s), jnp.stack(c_p), jnp.stack(c_s),
            jnp.stack(k_p), jnp.stack(v_p), jnp.stack(ki_p), jnp.stack(k_s), jnp.stack(v_s), jnp.stack(ki_s),
            jnp.stack(f_p), jnp.stack(f_s))
```

```cpp
#include <hip/hip_runtime.h>
#include <cstdio>
#include <cstdint>
namespace pg8 {
#define PG8_LAS __attribute__((address_space(3)))
typedef unsigned short bf16_t;
typedef short bf16x8 __attribute__((ext_vector_type(8)));
typedef float f32x4 __attribute__((ext_vector_type(4)));
typedef unsigned u32x4 __attribute__((ext_vector_type(4)));
constexpr int BM = 256, BK = 64, HALF = 128, HTB = HALF * BK * 2  , STAGE_BYTES = 8 * HTB, NXCD = 8, WGM = 8;

__host__ __device__ __forceinline__ int lds_byte(int r, int c) { const int st = (r >> 4) * 2 + (c >> 5), rr = r & 15, cc = c & 31, ob = rr * 64 + cc * 2; return st * 1024 + (ob ^ (((ob >> 9) & 1) << 5)); }
__host__ __device__ __forceinline__ void stage_rc(int b, int& R, int& C) { const int st = b / 1024, sb = b % 1024, swz = sb ^ (((sb >> 9) & 1) << 5); R = (st >> 1) * 16 + swz / 64; C = (st & 1) * 32 + (swz % 64) / 2; }
__host__ __device__ __forceinline__ int perm32(int rho) { const int n = rho >> 4, i = rho & 15; return 8 * (i >> 2) + 4 * n + (i & 3); }

struct Unit { int pm, pn; };
struct Gemm { const bf16_t* A; const bf16_t* Bt; int M, N, K; };

struct StaticOrder {
    int nM, nN, nwg, G, c;
    __host__ __device__ void init(int M, int N, int G_, int c_) { nM = M / BM; nN = N / BM; nwg = nM * nN; G = G_; c = c_; }
    __host__ __device__ bool next(int i, Unit& u) const {
        const long L = (long)i * G + c; if (L >= nwg) return false;
        int wgid = (int)L; { const int q = nwg / NXCD, r = nwg % NXCD, xcd = wgid % NXCD, off = wgid / NXCD; wgid = (xcd < r ? xcd * (q + 1) : r * (q + 1) + (xcd - r) * q) + off; }
        const int nig = WGM * nN, gid = wgid / nig, fm = gid * WGM, gsz = (nM - fm) < WGM ? (nM - fm) : WGM;
        u.pm = fm + ((wgid % nig) % gsz); u.pn = (wgid % nig) / gsz; return true;
    }
    __device__ __forceinline__ void a_ready(const Unit&) const {}
    __device__ __forceinline__ void done(const Unit&) const {}
};

__device__ __forceinline__ unsigned cvt_pk_bf16(float lo, float hi) { unsigned r; asm volatile("v_cvt_pk_bf16_f32 %0, %1, %2" : "=v"(r) : "v"(lo), "v"(hi)); return r; }
struct EpiF32 {
    static constexpr bool PERM = true, AFTER_DRAIN = false;
    float* C; int ldc;
    __device__ __forceinline__ void operator()(const f32x4 (&acc)[2][2][4][2], const Unit& u, int wr, int wc, int fr, int fq) const {
        const int row0 = u.pm * BM + wr * 64 + fr, col0 = u.pn * BM + wc * 32 + 8 * fq;
#pragma unroll
        for (int ai = 0; ai < 2; ++ai)
#pragma unroll
            for (int m = 0; m < 4; ++m) { float* rowp = C + (size_t)(row0 + ai * HALF + m * 16) * ldc + col0;
#pragma unroll
                for (int bj = 0; bj < 2; ++bj) { *(f32x4*)(rowp + bj * HALF) = acc[ai][bj][m][0]; *(f32x4*)(rowp + bj * HALF + 4) = acc[ai][bj][m][1]; } }
    }
};
template <class Epi, class Sched, bool ALIGN_EPI = false, bool SP2 = false>
__device__ __forceinline__ void gemm_phase(PG8_LAS unsigned char* lds, const Gemm g, const Sched& S, const Epi& E) {
    const int tid = threadIdx.x, wid = __builtin_amdgcn_readfirstlane(tid >> 6), lane = tid & 63, wr = wid >> 2, wc = wid & 3, fr = lane & 15, fq = lane >> 4;
    const int K = g.K, nt = K / BK;
    unsigned voffA[2], voffB[2];
#pragma unroll
    for (int i = 0; i < 2; ++i) { int R, C; stage_rc(tid * 16 + i * 8192, R, C); const int Rb = Epi::PERM ? ((R & ~31) + perm32(R & 31)) : R;
        voffA[i] = (unsigned)(R * K + C) * 2u; voffB[i] = (unsigned)(Rb * K + C) * 2u; }
    const size_t kstep = (size_t)(BK * 2);
    const size_t hstep = (size_t)HALF * K * 2;
    const size_t tstep = 2 * hstep;
    const unsigned ldsw = (unsigned)wid * 1024u;
    const int aoff = lds_byte(wr * 64 + fr, fq * 8), boff = lds_byte(wc * 32 + fr, fq * 8);
#define PG8_SA(b, h) (((b) * 2 + (h)) * HTB)
#define PG8_SB(b, h) ((4 + (b) * 2 + (h)) * HTB)
#define PG8_STAGE(bufoff, gbase, voff) do { _Pragma("unroll") for (int _i = 0; _i < 2; ++_i) \
        __builtin_amdgcn_global_load_lds((const unsigned*)((const char*)(gbase) + (voff)[_i]), (PG8_LAS unsigned*)(lds + (bufoff) + ldsw + _i * 8192), 16, 0, 0); } while (0)
#define PG8_LDA(dst, b, h) do { _Pragma("unroll") for (int m = 0; m < 4; ++m) _Pragma("unroll") for (int k = 0; k < 2; ++k) dst[m][k] = *(const PG8_LAS bf16x8*)(lds + PG8_SA(b, h) + aoff + m * 2048 + k * 1024); } while (0)
#define PG8_LDB(dst, b, h) do { _Pragma("unroll") for (int n = 0; n < 2; ++n) _Pragma("unroll") for (int k = 0; k < 2; ++k) dst[n][k] = *(const PG8_LAS bf16x8*)(lds + PG8_SB(b, h) + boff + n * 2048 + k * 1024); } while (0)
#define PG8_MMA(ai, bj, At, Bt) do { __builtin_amdgcn_s_setprio(1); _Pragma("unroll") for (int m = 0; m < 4; ++m) _Pragma("unroll") for (int n = 0; n < 2; ++n) _Pragma("unroll") for (int k = 0; k < 2; ++k) \
        acc[ai][bj][m][n] = __builtin_amdgcn_mfma_f32_16x16x32_bf16(Bt[n][k], At[m][k], acc[ai][bj][m][n], 0, 0, 0); __builtin_amdgcn_s_setprio(0); } while (0)
#define PG8_WAIT_V(n) asm volatile("s_waitcnt vmcnt(" #n ")" ::: "memory")
#define PG8_WAIT_L(n) asm volatile("s_waitcnt lgkmcnt(" #n ")" ::: "memory")
#define PG8_BAR __builtin_amdgcn_s_barrier()
#define PG8_SCHED __builtin_amdgcn_sched_barrier(0)
    Unit cur, nxt; int ui = 0;
    if (!S.next(0, cur)) return;
    f32x4 acc[2][2][4][2];
#pragma unroll
    for (int a = 0; a < 2; ++a)
#pragma unroll
        for (int b = 0; b < 2; ++b)
#pragma unroll
            for (int m = 0; m < 4; ++m)
#pragma unroll
                for (int n = 0; n < 2; ++n) acc[a][b][m][n] = (f32x4){0.f, 0.f, 0.f, 0.f};
    bf16x8 At[4][2], B0[2][2], B1[2][2];
    const char* cA = (const char*)g.A + (size_t)cur.pm * tstep; const char* cB = (const char*)g.Bt + (size_t)cur.pn * tstep;
    S.a_ready(cur);
    if constexpr (SP2) {
        PG8_STAGE(PG8_SB(0, 0), cB, voffB); PG8_STAGE(PG8_SB(0, 1), cB + hstep, voffB); PG8_STAGE(PG8_SA(0, 0), cA, voffA); PG8_STAGE(PG8_SA(0, 1), cA + hstep, voffA);
        if (wr == 1) PG8_BAR;
        PG8_WAIT_V(2); PG8_BAR;
        PG8_STAGE(PG8_SB(1, 0), cB + kstep, voffB); PG8_STAGE(PG8_SA(1, 0), cA + kstep, voffA); PG8_STAGE(PG8_SB(1, 1), cB + hstep + kstep, voffB);
        PG8_WAIT_V(6); PG8_BAR;
    } else {
        PG8_STAGE(PG8_SB(0, 0), cB, voffB); PG8_STAGE(PG8_SA(0, 0), cA, voffA); PG8_STAGE(PG8_SB(0, 1), cB + hstep, voffB); PG8_STAGE(PG8_SA(0, 1), cA + hstep, voffA);
        if (wr == 1) PG8_BAR;
        PG8_WAIT_V(4); PG8_BAR;
        PG8_STAGE(PG8_SB(1, 0), cB + kstep, voffB); PG8_STAGE(PG8_SA(1, 0), cA + kstep, voffA); PG8_STAGE(PG8_SB(1, 1), cB + hstep + kstep, voffB);
        PG8_WAIT_V(6); PG8_BAR;
    }
    for (;;) {
        const bool has_next = S.next(ui + 1, nxt);
        const char* nA = has_next ? (const char*)g.A + (size_t)nxt.pm * tstep : cA; const char* nB = has_next ? (const char*)g.Bt + (size_t)nxt.pn * tstep : cB;
        for (int t = 0; t < nt; t += 2) {
            const bool last = (t == nt - 2);
            const char* a1 = cA + (size_t)(t + 1) * kstep;
            const char* a2 = last ? nA : cA + (size_t)(t + 2) * kstep; const char* b2 = last ? nB : cB + (size_t)(t + 2) * kstep;
            const char* a3 = a2 + kstep; const char* b3 = b2 + kstep;
            if (last && has_next) S.a_ready(nxt);
            if constexpr (SP2) {
            PG8_LDB(B0, 0, 0); PG8_LDB(B1, 0, 1); PG8_SCHED; PG8_LDA(At, 0, 0); PG8_STAGE(PG8_SA(1, 1), a1 + hstep, voffA);
            PG8_WAIT_V(8); PG8_WAIT_L(0); PG8_BAR; PG8_MMA(0, 0, At, B0); PG8_MMA(0, 1, At, B1); PG8_BAR; PG8_SCHED;
            PG8_LDA(At, 0, 1); PG8_STAGE(PG8_SB(0, 0), b2, voffB); PG8_STAGE(PG8_SB(0, 1), b2 + hstep, voffB); PG8_STAGE(PG8_SA(0, 0), a2, voffA);
            PG8_WAIT_V(8); PG8_WAIT_L(0); PG8_BAR; PG8_MMA(1, 0, At, B0); PG8_MMA(1, 1, At, B1); PG8_BAR; PG8_SCHED;
            PG8_LDB(B0, 1, 0); PG8_LDB(B1, 1, 1); PG8_SCHED; PG8_LDA(At, 1, 0); PG8_STAGE(PG8_SA(0, 1), a2 + hstep, voffA);
            PG8_WAIT_V(8); PG8_WAIT_L(0); PG8_BAR; PG8_MMA(0, 0, At, B0); PG8_MMA(0, 1, At, B1); PG8_BAR; PG8_SCHED;
            PG8_LDA(At, 1, 1); PG8_STAGE(PG8_SB(1, 0), b3, voffB); PG8_STAGE(PG8_SB(1, 1), b3 + hstep, voffB); PG8_STAGE(PG8_SA(1, 0), a3, voffA);
            PG8_WAIT_V(8); PG8_WAIT_L(0); PG8_BAR; PG8_MMA(1, 0, At, B0); PG8_MMA(1, 1, At, B1); PG8_BAR; PG8_SCHED;
            } else {
            PG8_LDB(B0, 0, 0); PG8_SCHED; PG8_LDA(At, 0, 0); PG8_STAGE(PG8_SA(1, 1), a1 + hstep, voffA);
            PG8_WAIT_L(8); PG8_BAR; PG8_WAIT_L(0); PG8_MMA(0, 0, At, B0); PG8_BAR; PG8_SCHED;
            PG8_LDB(B1, 0, 1); PG8_STAGE(PG8_SB(0, 0), b2, voffB);
            PG8_BAR; PG8_WAIT_L(0); PG8_MMA(0, 1, At, B1); PG8_BAR;
            PG8_LDA(At, 0, 1); PG8_STAGE(PG8_SA(0, 0), a2, voffA);
            PG8_BAR; PG8_WAIT_L(0); PG8_MMA(1, 0, At, B0); PG8_BAR; PG8_SCHED;
            PG8_STAGE(PG8_SB(0, 1), b2 + hstep, voffB);
            PG8_WAIT_V(6); PG8_BAR; PG8_MMA(1, 1, At, B1); PG8_BAR;
            PG8_LDB(B0, 1, 0); PG8_SCHED; PG8_LDA(At, 1, 0); PG8_STAGE(PG8_SA(0, 1), a2 + hstep, voffA);
            PG8_WAIT_L(8); PG8_BAR; PG8_WAIT_L(0); PG8_MMA(0, 0, At, B0); PG8_BAR; PG8_SCHED;
            PG8_LDB(B1, 1, 1); PG8_STAGE(PG8_SB(1, 0), b3, voffB);
            PG8_BAR; PG8_WAIT_L(0); PG8_MMA(0, 1, At, B1); PG8_BAR;
            PG8_LDA(At, 1, 1); PG8_STAGE(PG8_SA(1, 0), a3, voffA);
            PG8_BAR; PG8_WAIT_L(0); PG8_MMA(1, 0, At, B0); PG8_BAR; PG8_SCHED;
            PG8_STAGE(PG8_SB(1, 1), b3 + hstep, voffB);
            PG8_WAIT_V(6); PG8_BAR; PG8_MMA(1, 1, At, B1); PG8_BAR;
            }
        }
        if constexpr (ALIGN_EPI) { if (wr == 0) PG8_BAR; }
        if constexpr (!Epi::AFTER_DRAIN) { E(acc, cur, wr, wc, fr, fq); S.done(cur); }
        if (!has_next) break;
#pragma unroll
        for (int a = 0; a < 2; ++a)
#pragma unroll
            for (int b = 0; b < 2; ++b)
#pragma unroll
                for (int m = 0; m < 4; ++m)
#pragma unroll
                    for (int n = 0; n < 2; ++n) acc[a][b][m][n] = (f32x4){0.f, 0.f, 0.f, 0.f};
        cur = nxt; cA = nA; cB = nB; ++ui;
        if constexpr (ALIGN_EPI) { if (wr == 1) PG8_BAR; }
    }
    PG8_WAIT_V(0);
    if constexpr (!ALIGN_EPI) { if (wr == 0) PG8_BAR; }
    PG8_BAR;
    if constexpr (Epi::AFTER_DRAIN) { E.fused(acc, cur, wr, wc, fr, fq, lds, wid, lane); S.done(cur); }
#undef PG8_SA
#undef PG8_SB
#undef PG8_STAGE
#undef PG8_LDA
#undef PG8_LDB
#undef PG8_MMA
#undef PG8_WAIT_V
#undef PG8_WAIT_L
#undef PG8_BAR
#undef PG8_SCHED
}
}
constexpr int NWAVES = 8, NTHR = 512;
constexpr int NP = 16384, NSR = 512, M = NP + NSR;
constexpr int D = 1024, SEQ = 4096, NB = 4, NSQ = 128, TS = 4, PAST = 2048, PAGE = 128, NPAGES = 16;
constexpr int DFF = 2816, DFF2 = 5632, ECOLS = 2560, OCOLS = 2632, OCOLS_P = 2816, AW = 512, TOPK = 256;
constexpr float ALPHA = 1.4142135623730951f, LN_EPS = 1e-5f, ATT_SCALE = 0.125f;
constexpr int E_U = 0, E_V = 512, E_B = 1024, E_C = 1536, E_H = 2048;
constexpr int O_P = 0, O_Q = 512, O_K = 1024, O_V = 1536, O_QI = 2048, O_KI = 2560, O_WI = 2624;
constexpr size_t OUT_YP = 0, OUT_YS = OUT_YP + (size_t)NP * D, OUT_AV = OUT_YS + (size_t)NSR * D, OUT_BP = OUT_AV + (size_t)NSR * AW,
    OUT_BS = OUT_BP + (size_t)NB * 2 * 512, OUT_CP = OUT_BS + (size_t)NSQ * 2 * 512, OUT_CS = OUT_CP + (size_t)NB * 15 * 512, OUT_KP = OUT_CS + (size_t)NSQ * 15 * 512,
    OUT_VP = OUT_KP + (size_t)NP * 512, OUT_KIP = OUT_VP + (size_t)NP * 512, OUT_KS = OUT_KIP + (size_t)NP * 64, OUT_VS = OUT_KS + (size_t)NSR * 512,
    OUT_KIS = OUT_VS + (size_t)NSR * 512, OUT_FP = OUT_KIS + (size_t)NSR * 64, OUT_FS = OUT_FP + (size_t)2 * NB * 2 * DFF2, OUT_END = OUT_FS + (size_t)2 * NSQ * 2 * DFF2;
static_assert(OUT_END == 40069120, "output size");
constexpr size_t MiB = 1u << 20;
constexpr size_t WS_CTL = 0, CTL_ZERO_BYTES = 1 * MiB;
constexpr size_t WS_ROPE = 1 * MiB;
constexpr size_t WS_WINE = 2 * MiB, WS_WOUTE = 7 * MiB, WS_WINO = 9 * MiB, WS_WOUTO = 15 * MiB, WS_WUP = 17 * MiB, WS_WDN = 39 * MiB;
constexpr size_t WUP_BYTES = (size_t)DFF2 * D * 2, WDN_BYTES = (size_t)D * DFF * 2;
static_assert(WS_WUP + 2 * WUP_BYTES <= WS_WDN && WS_WDN + 2 * WDN_BYTES <= 52 * MiB, "weights");
constexpr size_t WS_XB0 = 64 * MiB;
constexpr size_t WS_XF0 = 128 * MiB, WS_XF1 = 196 * MiB;
constexpr size_t WS_XBF0 = 264 * MiB, WS_XBF1 = 298 * MiB;
constexpr size_t WS_H = 512 * MiB;
constexpr size_t WS_AO = 704 * MiB;
constexpr size_t WS_Y = 768 * MiB;
constexpr size_t WS_HU = 1024 * MiB;
constexpr size_t WS_G = 1408 * MiB;
constexpr size_t WS_QR = 1536 * MiB, WS_KR = 1570 * MiB, WS_QI = 1604 * MiB, WS_KI = 1638 * MiB;
constexpr size_t WS_SEL = 1680 * MiB, WS_NSEL = 1698 * MiB;
constexpr size_t WS_SC = 1700 * MiB;
constexpr size_t WS_END = 1764 * MiB;
constexpr int CW_BAR = 4096;
constexpr int RING_BYTES = 131072, LDSCTL_OFF = RING_BYTES, MISC_OFF = LDSCTL_OFF + 320, LDS_BYTES = 147456;

#define GAS __attribute__((address_space(1)))
#define LAS __attribute__((address_space(3)))
typedef unsigned short bf16;
typedef unsigned v4u __attribute__((ext_vector_type(4)));
typedef unsigned v2u __attribute__((ext_vector_type(2)));
typedef float f32x4 __attribute__((ext_vector_type(4)));
typedef GAS unsigned gu32;
#define RLX_AGENT __ATOMIC_RELAXED, __HIP_MEMORY_SCOPE_AGENT
#define LDS_WAIT() asm volatile("s_waitcnt lgkmcnt(0)" ::: "memory")
#define VM_WAIT() asm volatile("s_waitcnt vmcnt(0)" ::: "memory")
__device__ __forceinline__ unsigned f2bf(float f) { unsigned u = __builtin_bit_cast(unsigned, f); return (u + 0x7fffu + ((u >> 16) & 1u)) >> 16; }
__device__ __forceinline__ unsigned pk2(float lo, float hi) { return f2bf(lo) | (f2bf(hi) << 16); }
__device__ __forceinline__ float gelu_t(float x) { const float t = x * (1.f + 0.044715f * x * x); const float e = __builtin_amdgcn_exp2f(-2.302208198f * t); return x / (1.f + e); }
__device__ __forceinline__ float silu_f(float x) { const float e = __builtin_amdgcn_exp2f(-1.4426950408889634f * x); return x / (1.f + e); }
__device__ __forceinline__ float wave_sum(float v) {
#pragma unroll
    for (int o = 1; o < 64; o <<= 1) v += __shfl_xor(v, o);
    return v;
}
#define XB_TMO      128
#define XB_XCNT(j)  (256  + 64 * (j))
#define XB_XSUB(j)  (1280 + 64 * (j))
#define XB_XGEN(j)  (2304 + 64 * (j))
#define XB_TOP      3328
#define XB_TOPGEN   3392
#define XCD_BAR_WORDS 3456
#define XB_SPIN_CAP (1u << 18)

__device__ __forceinline__ unsigned xb_ld(unsigned* p)              { return __hip_atomic_load(p, __ATOMIC_RELAXED, __HIP_MEMORY_SCOPE_AGENT); }
__device__ __forceinline__ unsigned xb_add(unsigned* p, unsigned v) { return __hip_atomic_fetch_add(p, v, __ATOMIC_RELAXED, __HIP_MEMORY_SCOPE_AGENT); }
__device__ __forceinline__ unsigned xb_xcc_id() { return (unsigned)__builtin_amdgcn_s_getreg((3 << 11) | 20) & 0xFu; }
#define XB_SPIN(cond, bar) do { unsigned _sp = 0; while (cond) { __builtin_amdgcn_s_sleep(1); \
    if ((++_sp & 255u) == 0u) { if (xb_ld(&(bar)[XB_TMO])) break; if (_sp > XB_SPIN_CAP) { atomicAdd(&(bar)[XB_TMO], 1u); break; } } } } while (0)

struct XcdBarrier {
    unsigned* bar; unsigned x;
    volatile LAS unsigned* st;
};

__device__ __forceinline__ XcdBarrier xcd_barrier_post(unsigned* bar, volatile LAS unsigned* st) {
    XcdBarrier b; b.bar = bar; b.x = xb_xcc_id(); b.st = st;
    if (threadIdx.x == 0) (void)xb_add(&bar[XB_XCNT(b.x)], 1u);
    return b;
}
__device__ __forceinline__ void xcd_barrier_complete(unsigned* bar, unsigned x, unsigned& nloc, unsigned& nx) {
    const unsigned G = gridDim.x * gridDim.y * gridDim.z;
    unsigned sum, cnt, mine, sp = 0u;
    for (;;) {
        sum = 0u; cnt = 0u; mine = 0u;
#pragma unroll
        for (unsigned j = 0; j < 16; ++j) { const unsigned c = xb_ld(&bar[XB_XCNT(j)]); sum += c; cnt += (c > 0u) ? 1u : 0u; mine = (j == x) ? c : mine; }
        if (sum == G) break;
        __builtin_amdgcn_s_sleep(1);
        if ((++sp & 255u) == 0u) { if (xb_ld(&bar[XB_TMO])) break; if (sp > XB_SPIN_CAP) { atomicAdd(&bar[XB_TMO], 1u); break; } }
    }
    nloc = mine > 0u ? mine : 1u; nx = cnt > 0u ? cnt : 1u;
}

__device__ __forceinline__ void xcd_barrier(const XcdBarrier& b) {
    asm volatile("s_waitcnt vmcnt(0)" ::: "memory");
    __syncthreads();
    if (threadIdx.x == 0) {
        unsigned* bar = b.bar;
        __builtin_amdgcn_s_waitcnt(0);
        unsigned nloc = b.st[0], nx = b.st[1];
        if (nloc == 0u) { xcd_barrier_complete(bar, b.x, nloc, nx); b.st[0] = nloc; b.st[1] = nx; }
        const unsigned old = xb_add(&bar[XB_XSUB(b.x)], 1u);
        const unsigned gen = old / nloc;
        if (old + 1u == (gen + 1u) * nloc) {
            __builtin_amdgcn_fence(__ATOMIC_RELEASE, "agent");
            asm volatile("s_waitcnt vmcnt(0)" ::: "memory");
            const unsigned og = xb_add(&bar[XB_TOP], 1u);
            const unsigned tg = og / nx;
            if (og + 1u == (tg + 1u) * nx) xb_add(&bar[XB_TOPGEN], 1u);
            else XB_SPIN(xb_ld(&bar[XB_TOPGEN]) == tg, bar);
            __builtin_amdgcn_fence(__ATOMIC_ACQUIRE, "agent");
            xb_add(&bar[XB_XGEN(b.x)], 1u);
            asm volatile("s_waitcnt vmcnt(0)" ::: "memory");
        } else {
            XB_SPIN(xb_ld(&bar[XB_XGEN(b.x)]) == gen, bar);
            __builtin_amdgcn_fence(__ATOMIC_ACQUIRE, "agent");
            asm volatile("s_waitcnt vmcnt(0)" ::: "memory");
        }
    }
    __syncthreads();
}
struct Frame {
    LAS unsigned char* lds;
    volatile LAS unsigned* MISC;
    gu32* ctl;
    int tid, lane, wave, vcu, G;
    const float* in[28];
    float* out; unsigned char* ws;
};
#define INP(i) (F.in[i])
__device__ __forceinline__ const float* xrow_in(const Frame& F, int r) { return r < NP ? INP(0) + (size_t)r * D : INP(1) + (size_t)(r - NP) * D; }

__device__ __forceinline__ void p0_transpose_item(const float* W, int K, int N, int nblk, bf16* WT, LAS float* scr, int item, int lane) {
    const int kb = item / nblk, nb = item % nblk, k0 = 64 * kb, n0 = 32 * nb;
    const int nn = n0 + (lane & 31);
#pragma unroll 8
    for (int i = 0; i < 32; ++i) { const int kk = 2 * i + (lane >> 5); scr[kk * 33 + (lane & 31)] = (nn < N) ? W[(size_t)(k0 + kk) * N + nn] : 0.f; }
    LDS_WAIT(); asm volatile("" ::: "memory");
    const int c = lane & 7;
#pragma unroll
    for (int j = 0; j < 4; ++j) { const int n = (lane >> 3) + 8 * j; const LAS float* s = scr + (8 * c) * 33 + n;
        v4u o; o.x = pk2(s[0 * 33], s[1 * 33]); o.y = pk2(s[2 * 33], s[3 * 33]); o.z = pk2(s[4 * 33], s[5 * 33]); o.w = pk2(s[6 * 33], s[7 * 33]);
        *(GAS v4u*)(WT + (size_t)(n0 + n) * K + k0 + 8 * c) = o; }
    LDS_WAIT(); asm volatile("" ::: "memory");
}
__device__ __forceinline__ void p0_prologue(Frame& F) {
    LAS float* scr = (LAS float*)(F.lds + F.wave * 16384);
    const int gw = F.vcu * NWAVES + F.wave, NGW = F.G * NWAVES;
    constexpr int I_INE = 16 * 80, I_SQ = 16 * 32, I_INO = 16 * 88, I_UP = 16 * 176, I_DN = 44 * 32;
    constexpr int NITEMS = I_INE + I_SQ + I_INO + I_SQ + 2 * I_UP + 2 * I_DN;
    for (int it = gw; it < NITEMS; it += NGW) {
        int r = it;
        if (r < I_INE) { p0_transpose_item(INP(9), D, ECOLS, 80, (bf16*)(F.ws + WS_WINE), scr, r, F.lane); continue; } r -= I_INE;
        if (r < I_SQ) { p0_transpose_item(INP(15), D, D, 32, (bf16*)(F.ws + WS_WOUTE), scr, r, F.lane); continue; } r -= I_SQ;
        if (r < I_INO) { p0_transpose_item(INP(16), D, OCOLS, 88, (bf16*)(F.ws + WS_WINO), scr, r, F.lane); continue; } r -= I_INO;
        if (r < I_SQ) { p0_transpose_item(INP(19), D, D, 32, (bf16*)(F.ws + WS_WOUTO), scr, r, F.lane); continue; } r -= I_SQ;
        if (r < 2 * I_UP) { const int l = r / I_UP; p0_transpose_item(INP(22) + (size_t)l * D * DFF2, D, DFF2, 176, (bf16*)(F.ws + WS_WUP + l * WUP_BYTES), scr, r % I_UP, F.lane); continue; } r -= 2 * I_UP;
        { const int l = r / I_DN; p0_transpose_item(INP(25) + (size_t)l * DFF * D, DFF, D, 32, (bf16*)(F.ws + WS_WDN + l * WDN_BYTES), scr, r % I_DN, F.lane); }
    }
    bf16* XB = (bf16*)(F.ws + WS_XB0);
    for (int r = gw; r < M; r += NGW) {
        const f32x4* xr = (const f32x4*)xrow_in(F, r) + F.lane;
        unsigned long long* o8 = (unsigned long long*)(XB + (size_t)r * D) + F.lane;
#pragma unroll
        for (int j = 0; j < 4; ++j) { const f32x4 v = xr[64 * j]; o8[64 * j] = (unsigned long long)pk2(v.x, v.y) | ((unsigned long long)pk2(v.z, v.w) << 32); }
    }
    {
        float* ct = (float*)(F.ws + WS_ROPE); float* st = ct + 4096 * 8;
        const int gt = F.vcu * NTHR + F.tid;
        if (gt < 4096 * 8) {
            const int pos = gt >> 3, i = gt & 7;
            const float invs[8] = {1.0f, 0.1939227432012558f, 0.03760603070259094f, 0.007292664609849453f, 0.0014142135623842478f, 0.00027424818836152554f, 5.318296098266728e-05f, 1.0313386155758053e-05f};
            float inv = invs[0];
#pragma unroll
            for (int k = 1; k < 8; ++k) inv = (i == k) ? invs[k] : inv;
            const float angf = (float)pos * inv;
            const double a = (double)angf;
            const double n = __builtin_rint(a * 0.15915494309189535);
            double x = __builtin_fma(-n, 6.283185307179586, a); x = __builtin_fma(-n, 2.4492935982947064e-16, x);
            const double x2 = x * x;
            double sn = 1.0 / 51090942171709440000.0;
            sn = sn * x2 - 1.0 / 121645100408832000.0; sn = sn * x2 + 1.0 / 355687428096000.0; sn = sn * x2 - 1.0 / 1307674368000.0; sn = sn * x2 + 1.0 / 6227020800.0;
            sn = sn * x2 - 1.0 / 39916800.0; sn = sn * x2 + 1.0 / 362880.0; sn = sn * x2 - 1.0 / 5040.0; sn = sn * x2 + 1.0 / 120.0; sn = sn * x2 - 1.0 / 6.0; sn = sn * x2 + 1.0; sn = sn * x;
            double cs = 1.0 / 2432902008176640000.0;
            cs = cs * x2 - 1.0 / 6402373705728000.0; cs = cs * x2 + 1.0 / 20922789888000.0; cs = cs * x2 - 1.0 / 87178291200.0; cs = cs * x2 + 1.0 / 479001600.0;
            cs = cs * x2 - 1.0 / 3628800.0; cs = cs * x2 + 1.0 / 40320.0; cs = cs * x2 - 1.0 / 720.0; cs = cs * x2 + 1.0 / 24.0; cs = cs * x2 - 0.5; cs = cs * x2 + 1.0;
            ct[gt] = (float)cs; st[gt] = (float)sn;
        }
    }
}

__device__ __forceinline__ void ln_phase(Frame& F, const float* resP, const float* resS, const float* Y, const float* g, const float* b, float* outF, bf16* outB) {
    const int gw = F.vcu * NWAVES + F.wave, NGW = F.G * NWAVES;
    f32x4 gv[4], bv[4];
#pragma unroll
    for (int j = 0; j < 4; ++j) { gv[j] = *((const f32x4*)g + F.lane + 64 * j); bv[j] = *((const f32x4*)b + F.lane + 64 * j); }
    for (int r = gw; r < M; r += NGW) {
        const f32x4* rr = (const f32x4*)(r < NP ? resP + (size_t)r * D : resS + (size_t)(r - NP) * D) + F.lane;
        const f32x4* yr = (const f32x4*)(Y + (size_t)r * D) + F.lane;
        f32x4 v[4]; float s = 0.f;
#pragma unroll
        for (int j = 0; j < 4; ++j) { v[j] = rr[64 * j] * ALPHA + yr[64 * j]; s += (v[j].x + v[j].y) + (v[j].z + v[j].w); }
        const float mean = wave_sum(s) * (1.f / D); float s2 = 0.f;
#pragma unroll
        for (int j = 0; j < 4; ++j) { v[j] = v[j] - mean; s2 += (v[j].x * v[j].x + v[j].y * v[j].y) + (v[j].z * v[j].z + v[j].w * v[j].w); }
        const float rstd = 1.f / sqrtf(wave_sum(s2) * (1.f / D) + LN_EPS);
        f32x4* of = (f32x4*)(outF + (size_t)r * D) + F.lane;
#pragma unroll
        for (int j = 0; j < 4; ++j) { v[j] = v[j] * rstd * gv[j] + bv[j]; of[64 * j] = v[j]; }
        if (outB) { unsigned long long* o8 = (unsigned long long*)(outB + (size_t)r * D) + F.lane;
#pragma unroll
            for (int j = 0; j < 4; ++j) o8[64 * j] = (unsigned long long)pk2(v[j].x, v[j].y) | ((unsigned long long)pk2(v[j].z, v[j].w) << 32); }
    }
}
__device__ __forceinline__ void p2_mixer_even(Frame& F) {
    const float* H0 = (const float*)(F.ws + WS_H);
    bf16* AO = (bf16*)(F.ws + WS_AO);
    const float* a_g = INP(10); const float* a_b = INP(11); const float* a_ws = INP(12); const float* a_bs = INP(13); const float* bcw = INP(14);
    LAS float* Vn = (LAS float*)F.lds;
    for (int u = F.vcu; u < 512 + NSQ; u += F.G) {
        if (u < 512) {
            const int g = u & 3, chunk = (u >> 2) & 31, b = u >> 7, R0 = b * SEQ + chunk * 128;
#pragma unroll 2
            for (int i = 0; i < 16; ++i) {
                const int s = F.wave * 16 + i; const float* hp = H0 + (size_t)(R0 + s) * ECOLS + E_V + 8 * F.lane;
                const f32x4 a = *(const f32x4*)hp, c = *(const f32x4*)(hp + 4);
                float x[8] = {gelu_t(a.x), gelu_t(a.y), gelu_t(a.z), gelu_t(a.w), gelu_t(c.x), gelu_t(c.y), gelu_t(c.z), gelu_t(c.w)};
                float sm = 0.f;
#pragma unroll
                for (int k = 0; k < 8; ++k) sm += x[k];
                const float mean = wave_sum(sm) * (1.f / AW); float s2 = 0.f;
#pragma unroll
                for (int k = 0; k < 8; ++k) { x[k] -= mean; s2 += x[k] * x[k]; }
                const float rstd = 1.f / sqrtf(wave_sum(s2) * (1.f / AW) + LN_EPS);
                if ((F.lane >> 4) == g) {
                    const int c0 = 8 * F.lane;
#pragma unroll
                    for (int k = 0; k < 8; ++k) Vn[s * 132 + (c0 - 128 * g) + k] = x[k] * rstd * a_g[c0 + k] + a_b[c0 + k];
                }
            }
            __syncthreads();
            const int c4 = F.tid & 31, col = g * 128 + 4 * c4;
            const f32x4 w0 = *(const f32x4*)(bcw + col), w1 = *(const f32x4*)(bcw + 512 + col), w2 = *(const f32x4*)(bcw + 1024 + col);
            for (int i = 0; i < 8; ++i) {
                const int t = (F.tid >> 5) + 16 * i; const size_t r = (size_t)(R0 + t);
                const float* wrow = a_ws + (size_t)(g * 128 + t) * 128;
                f32x4 acc = {0.f, 0.f, 0.f, 0.f};
                for (int s = 0; s <= t; ++s) { const float w = wrow[s]; const f32x4 v = *(const LAS f32x4*)(Vn + s * 132 + 4 * c4); acc += v * w; }
                const float bs = a_bs[g * 128 + t];
                const f32x4 uu = *(const f32x4*)(H0 + r * ECOLS + E_U + col);
                const float o0 = gelu_t(uu.x) * (acc.x + bs), o1 = gelu_t(uu.y) * (acc.y + bs), o2 = gelu_t(uu.z) * (acc.z + bs), o3 = gelu_t(uu.w) * (acc.w + bs);
                *(v2u*)(AO + r * D + col) = (v2u){pk2(o0, o1), pk2(o2, o3)};
                const int tt = chunk * 128 + t;
                const f32x4 p0 = *(const f32x4*)(H0 + r * ECOLS + E_C + col) * *(const f32x4*)(H0 + r * ECOLS + E_H + col);
                f32x4 p1 = {0.f, 0.f, 0.f, 0.f}, p2 = {0.f, 0.f, 0.f, 0.f};
                if (tt >= 1) p1 = *(const f32x4*)(H0 + (r - 1) * ECOLS + E_C + col) * *(const f32x4*)(H0 + (r - 1) * ECOLS + E_H + col);
                if (tt >= 2) p2 = *(const f32x4*)(H0 + (r - 2) * ECOLS + E_C + col) * *(const f32x4*)(H0 + (r - 2) * ECOLS + E_H + col);
                const f32x4 cv = w2 * p0 + w1 * p1 + w0 * p2;
                const f32x4 bo = *(const f32x4*)(H0 + r * ECOLS + E_B + col) * cv;
                *(v2u*)(AO + r * D + 512 + col) = (v2u){pk2(bo.x, bo.y), pk2(bo.z, bo.w)};
                if (tt >= SEQ - 2) *(f32x4*)(F.out + OUT_BP + (size_t)(b * 2 + (tt - (SEQ - 2))) * 512 + col) = p0;
            }
            __syncthreads();
        } else {
            const int n = u - 512, R0 = NP + 4 * n;
            if (F.wave < 4) {
                const int t = F.wave; const float* hp = H0 + (size_t)(R0 + t) * ECOLS + E_V + 8 * F.lane;
                const f32x4 a = *(const f32x4*)hp, c = *(const f32x4*)(hp + 4);
                float x[8] = {gelu_t(a.x), gelu_t(a.y), gelu_t(a.z), gelu_t(a.w), gelu_t(c.x), gelu_t(c.y), gelu_t(c.z), gelu_t(c.w)};
                float sm = 0.f;
#pragma unroll
                for (int k = 0; k < 8; ++k) sm += x[k];
                const float mean = wave_sum(sm) * (1.f / AW); float s2 = 0.f;
#pragma unroll
                for (int k = 0; k < 8; ++k) { x[k] -= mean; s2 += x[k] * x[k]; }
                const float rstd = 1.f / sqrtf(wave_sum(s2) * (1.f / AW) + LN_EPS);
                const int c0 = 8 * F.lane;
#pragma unroll
                for (int k = 0; k < 8; ++k) { const float v = x[k] * rstd * a_g[c0 + k] + a_b[c0 + k]; Vn[t * 512 + c0 + k] = v; F.out[OUT_AV + (size_t)(n * 4 + t) * AW + c0 + k] = v; }
            }
            __syncthreads();
            {
                const int c = F.tid, g = c >> 7;
                float ext[6]; ext[0] = INP(2)[(size_t)(n * 2 + 0) * 512 + c]; ext[1] = INP(2)[(size_t)(n * 2 + 1) * 512 + c];
#pragma unroll
                for (int t = 0; t < 4; ++t) ext[2 + t] = H0[(size_t)(R0 + t) * ECOLS + E_C + c] * H0[(size_t)(R0 + t) * ECOLS + E_H + c];
                const float w0 = bcw[c], w1 = bcw[512 + c], w2 = bcw[1024 + c];
#pragma unroll
                for (int t = 0; t < 4; ++t) {
                    float mix = a_bs[g * 128 + t];
#pragma unroll
                    for (int s = 0; s <= t; ++s) mix += a_ws[(size_t)(g * 128 + t) * 128 + s] * Vn[s * 512 + c];
                    const float ao = gelu_t(H0[(size_t)(R0 + t) * ECOLS + E_U + c]) * mix;
                    const float cv = w2 * ext[t + 2] + w1 * ext[t + 1] + w0 * ext[t];
                    const float bo = H0[(size_t)(R0 + t) * ECOLS + E_B + c] * cv;
                    AO[(size_t)(R0 + t) * D + c] = (bf16)f2bf(ao); AO[(size_t)(R0 + t) * D + 512 + c] = (bf16)f2bf(bo);
                }
                F.out[OUT_BS + (size_t)(n * 2 + 0) * 512 + c] = ext[4]; F.out[OUT_BS + (size_t)(n * 2 + 1) * 512 + c] = ext[5];
            }
            __syncthreads();
        }
    }
}

__device__ __forceinline__ void conv_gate_phase(Frame& F, int layer) {
    const float* HU = (const float*)(F.ws + WS_HU); bf16* G = (bf16*)(F.ws + WS_G);
    const float* cw = INP(23) + (size_t)layer * 3 * DFF2; const float* cb = INP(24) + (size_t)layer * DFF2;
    const float* st = INP(7) + (size_t)layer * NSQ * 2 * DFF2;
    const int NV = DFF / 4;
    const long total = (long)M * NV;
    for (long it = (long)F.vcu * NTHR + F.tid; it < total; it += (long)F.G * NTHR) {
        const int r = (int)(it / NV), j = (int)(it % NV) * 4;
        f32x4 ha[3], hb[3];
        const float* cur = HU + (size_t)r * DFF2;
        ha[2] = *(const f32x4*)(cur + j); hb[2] = *(const f32x4*)(cur + DFF + j);
        if (r < NP) {
            const int t = r & (SEQ - 1);
            if (t >= 1) { ha[1] = *(const f32x4*)(cur - DFF2 + j); hb[1] = *(const f32x4*)(cur - DFF2 + DFF + j); } else { ha[1] = (f32x4){0.f, 0.f, 0.f, 0.f}; hb[1] = ha[1]; }
            if (t >= 2) { ha[0] = *(const f32x4*)(cur - 2 * DFF2 + j); hb[0] = *(const f32x4*)(cur - 2 * DFF2 + DFF + j); } else { ha[0] = (f32x4){0.f, 0.f, 0.f, 0.f}; hb[0] = ha[0]; }
        } else {
            const int n = (r - NP) >> 2, t = (r - NP) & 3;
            const float* s0 = st + (size_t)(n * 2 + 0) * DFF2; const float* s1 = st + (size_t)(n * 2 + 1) * DFF2;
            const float* e1 = (t >= 1) ? cur - DFF2 : s1;
            const float* e0 = (t >= 2) ? cur - 2 * DFF2 : (t == 1 ? s1 : s0);
            ha[1] = *(const f32x4*)(e1 + j); hb[1] = *(const f32x4*)(e1 + DFF + j);
            ha[0] = *(const f32x4*)(e0 + j); hb[0] = *(const f32x4*)(e0 + DFF + j);
        }
        f32x4 xa = *(const f32x4*)(cb + j), xb = *(const f32x4*)(cb + DFF + j);
#pragma unroll
        for (int k = 0; k < 3; ++k) { xa += ha[k] * *(const f32x4*)(cw + (size_t)k * DFF2 + j); xb += hb[k] * *(const f32x4*)(cw + (size_t)k * DFF2 + DFF + j); }
        const float g0 = silu_f(xa.x) * xb.x, g1 = silu_f(xa.y) * xb.y, g2 = silu_f(xa.z) * xb.z, g3 = silu_f(xa.w) * xb.w;
        *(v2u*)(G + (size_t)r * DFF + j) = (v2u){pk2(g0, g1), pk2(g2, g3)};
    }
    const int NV2 = DFF2 / 4;
    const long tot2 = (long)(NB + NSQ) * 2 * NV2;
    for (long it = (long)F.vcu * NTHR + F.tid; it < tot2; it += (long)F.G * NTHR) {
        const int j = (int)(it % NV2) * 4, q = (int)(it / NV2), k = q & 1, sq = q >> 1;
        if (sq < NB) *(f32x4*)(F.out + OUT_FP + ((size_t)(layer * NB + sq) * 2 + k) * DFF2 + j) = *(const f32x4*)(HU + (size_t)(sq * SEQ + SEQ - 2 + k) * DFF2 + j);
        else { const int n = sq - NB; *(f32x4*)(F.out + OUT_FS + ((size_t)(layer * NSQ + n) * 2 + k) * DFF2 + j) = *(const f32x4*)(HU + (size_t)(NP + 4 * n + 2 + k) * DFF2 + j); }
    }
}
__device__ __forceinline__ void p10_post_odd(Frame& F) {
    const float* H1 = (const float*)(F.ws + WS_H);
    float* QR = (float*)(F.ws + WS_QR); float* KR = (float*)(F.ws + WS_KR); float* QI = (float*)(F.ws + WS_QI); float* KI = (float*)(F.ws + WS_KI);
    bf16* AO = (bf16*)(F.ws + WS_AO);
    const float* ct = (const float*)(F.ws + WS_ROPE); const float* st = ct + 4096 * 8;
    const float* cwt = INP(17); const float* csc = INP(18); const float* spool = INP(3);
    LAS float* pl = (LAS float*)(F.lds + F.wave * 4096);
    const int gw = F.vcu * NWAVES + F.wave, NGW = F.G * NWAVES, lane = F.lane;
    for (int r = gw; r < M; r += NGW) {
        const bool smp = r >= NP; const int n = (r - NP) >> 2, tsm = (r - NP) & 3, b = r >> 12, t = r & (SEQ - 1);
        const int pos = smp ? PAST + tsm : t;
        const float* h = H1 + (size_t)r * OCOLS_P;
        const int sub = lane & 7;
        f32x4 cA = {1.f, 1.f, 1.f, 1.f}, cB = cA, sA = {0.f, 0.f, 0.f, 0.f}, sB = sA;
        if (sub < 2) { cA = *(const f32x4*)(ct + pos * 8); cB = *(const f32x4*)(ct + pos * 8 + 4); sA = *(const f32x4*)(st + pos * 8); sB = *(const f32x4*)(st + pos * 8 + 4);
            if (sub == 0) { sA = -sA; sB = -sB; } }
#pragma unroll
        for (int which = 0; which < 3; ++which) {
            const int cbase = which == 0 ? O_Q : (which == 1 ? O_K : O_QI);
            f32x4 a = *(const f32x4*)(h + cbase + 8 * lane), c = *(const f32x4*)(h + cbase + 8 * lane + 4);
            f32x4 oa, oc;
            oa.x = __shfl_xor(a.x, 1); oa.y = __shfl_xor(a.y, 1); oa.z = __shfl_xor(a.z, 1); oa.w = __shfl_xor(a.w, 1);
            oc.x = __shfl_xor(c.x, 1); oc.y = __shfl_xor(c.y, 1); oc.z = __shfl_xor(c.z, 1); oc.w = __shfl_xor(c.w, 1);
            if (sub < 2) { a = a * cA + oa * sA; c = c * cB + oc * sB; }
            float* dst = (which == 0 ? QR : (which == 1 ? KR : QI)) + (size_t)r * 512 + 8 * lane;
            *(f32x4*)dst = a; *(f32x4*)(dst + 4) = c;
            if (which == 1) { float* o = smp ? F.out + OUT_KS + (size_t)(r - NP) * 512 + 8 * lane : F.out + OUT_KP + (size_t)r * 512 + 8 * lane; *(f32x4*)o = a; *(f32x4*)(o + 4) = c; }
        }
        { const f32x4 a = *(const f32x4*)(h + O_V + 8 * lane), c = *(const f32x4*)(h + O_V + 8 * lane + 4);
          float* o = smp ? F.out + OUT_VS + (size_t)(r - NP) * 512 + 8 * lane : F.out + OUT_VP + (size_t)r * 512 + 8 * lane; *(f32x4*)o = a; *(f32x4*)(o + 4) = c; }
        { float v = h[O_KI + lane]; const float o = __shfl_xor(v, 8);
          if (lane < 16) { const float cc = ct[pos * 8 + (lane & 7)], ss = st[pos * 8 + (lane & 7)]; v = (lane < 8) ? v * cc - o * ss : v * cc + o * ss; }
          KI[(size_t)r * 64 + lane] = v;
          if (smp) F.out[OUT_KIS + (size_t)(r - NP) * 64 + lane] = v; else F.out[OUT_KIP + (size_t)r * 64 + lane] = v; }
        {
            const int g = lane >> 4, w = 2 << g;
            const f32x4 xa = *(const f32x4*)(h + O_P + 8 * lane), xc = *(const f32x4*)(h + O_P + 8 * lane + 4);
            f32x4 sa = xa, sc = xc; float cnt;
            if (!smp) {
                const int lim = (t + 1 < w) ? t + 1 : w; cnt = (float)lim;
                for (int j = 1; j < lim; ++j) { const float* hj = h - (size_t)j * OCOLS_P + O_P + 8 * lane; sa += *(const f32x4*)hj; sc += *(const f32x4*)(hj + 4); }
            } else {
                cnt = (float)w;
                for (int j = 1; j < w; ++j) { const int e = 15 + tsm - j;
                    const float* hj = (e >= 15) ? H1 + (size_t)(NP + 4 * n + (e - 15)) * OCOLS_P + O_P + 8 * lane : spool + (size_t)(n * 15 + e) * 512 + 8 * lane;
                    sa += *(const f32x4*)hj; sc += *(const f32x4*)(hj + 4); }
            }
            const float ic = 1.f / cnt;
            const f32x4 pa = sa * ic - xa, pc = sc * ic - xc;
            *(LAS f32x4*)(pl + 8 * lane) = pa; *(LAS f32x4*)(pl + 8 * lane + 4) = pc;
            if (!smp) { if (t >= SEQ - 15) { float* o = F.out + OUT_CP + (size_t)(b * 15 + (t - (SEQ - 15))) * 512 + 8 * lane; *(f32x4*)o = xa; *(f32x4*)(o + 4) = xc; } }
            else { float* o = F.out + OUT_CS + (size_t)(n * 15 + 11 + tsm) * 512 + 8 * lane; *(f32x4*)o = xa; *(f32x4*)(o + 4) = xc;
                if (tsm == 0) for (int i = 0; i < 11; ++i) { const float* s = spool + (size_t)(n * 15 + 4 + i) * 512 + 8 * lane; float* o2 = F.out + OUT_CS + (size_t)(n * 15 + i) * 512 + 8 * lane;
                    *(f32x4*)o2 = *(const f32x4*)s; *(f32x4*)(o2 + 4) = *(const f32x4*)(s + 4); } }
            LDS_WAIT(); asm volatile("" ::: "memory");
            const int d0 = 8 * (lane & 15);
            f32x4 a0 = {0.f, 0.f, 0.f, 0.f}, a1 = a0;
            const float* wg = cwt + (size_t)g * 128 * 128 + d0;
#pragma unroll 4
            for (int c = 0; c < 128; ++c) { const float p = pl[g * 128 + c]; a0 += *(const f32x4*)(wg + (size_t)c * 128) * p; a1 += *(const f32x4*)(wg + (size_t)c * 128 + 4) * p; }
            a0 = a0 * *(const f32x4*)(csc + g * 128 + d0); a1 = a1 * *(const f32x4*)(csc + g * 128 + d0 + 4);
            *(v4u*)(AO + (size_t)r * D + g * 128 + d0) = (v4u){pk2(a0.x, a0.y), pk2(a0.z, a0.w), pk2(a1.x, a1.y), pk2(a1.z, a1.w)};
            LDS_WAIT(); asm volatile("" ::: "memory");
        }
    }
}
__device__ __forceinline__ unsigned sortable(float f) { const unsigned u = __builtin_bit_cast(unsigned, f); return (u & 0x80000000u) ? ~u : (u | 0x80000000u); }
template <int NJ>
__device__ __forceinline__ int select_topk(const unsigned (&key)[NJ], int N, int lane, int* sel) {
    const unsigned long long lt = (1ull << lane) - 1ull;
    if (N <= TOPK) { for (int s = lane; s < N; s += 64) sel[s] = s; return N; }
    unsigned T = 0u;
#pragma unroll 1
    for (int bit = 31; bit >= 0; --bit) {
        const unsigned cand = T | (1u << bit); int cnt = 0;
#pragma unroll
        for (int j = 0; j < NJ; ++j) cnt += __builtin_popcountll(__ballot(key[j] >= cand));
        if (cnt >= TOPK) T = cand;
    }
    int cgt = 0;
#pragma unroll
    for (int j = 0; j < NJ; ++j) cgt += __builtin_popcountll(__ballot(key[j] > T));
    const int need = TOPK - cgt;
    int outpos = 0, tseen = 0;
#pragma unroll
    for (int j = 0; j < NJ; ++j) {
        const bool gt = key[j] > T, eq = key[j] == T;
        const unsigned long long beq = __ballot(eq);
        const int tr = tseen + __builtin_popcountll(beq & lt);
        const bool s_ = gt || (eq && tr < need);
        const unsigned long long bs = __ballot(s_);
        if (s_) sel[outpos + __builtin_popcountll(bs & lt)] = 64 * j + lane;
        outpos += __builtin_popcountll(bs); tseen += __builtin_popcountll(beq);
    }
    return outpos;
}
__device__ __forceinline__ void p11_index_select(Frame& F) {
    const float* QI = (const float*)(F.ws + WS_QI); const float* KI = (const float*)(F.ws + WS_KI); const float* H1 = (const float*)(F.ws + WS_H);
    int* SEL = (int*)(F.ws + WS_SEL); int* NSEL = (int*)(F.ws + WS_NSEL);
    float* SC = (float*)(F.ws + WS_SC) + (size_t)blockIdx.x * 16 * 4096;
    const int* ptab = (const int*)INP(8); const float* ckidx = INP(6);
    LAS float* q_l = (LAS float*)F.lds;
    LAS float* w_l = (LAS float*)(F.lds + 32768);
    for (int u = F.vcu; u < 1024 + NSQ; u += F.G) {
        int b = 0, qb = 0, n = -1;
        if (u < 1024) { const int w = u & 255, i = u >> 8; b = w & 3; const int j = w >> 2; qb = (i == 0) ? j : (i == 1) ? 127 - j : (i == 2) ? 128 + j : 255 - j; }
        else n = u - 1024;
        const bool smp = n >= 0;
        const int nq = smp ? 4 : 16, R0 = smp ? NP + 4 * n : b * SEQ + 16 * qb, nk = smp ? PAST + 4 : 16 * (qb + 1);
        for (int e = F.tid; e < nq * 512 / 4; e += NTHR) *(LAS f32x4*)(q_l + 4 * e) = *(const f32x4*)(QI + (size_t)R0 * 512 + 4 * e);
        if (F.tid < nq * 8) w_l[F.tid] = H1[(size_t)(R0 + (F.tid >> 3)) * OCOLS_P + O_WI + (F.tid & 7)];
        __syncthreads();
        for (int s = F.tid; s < nk; s += NTHR) {
            const float* kp;
            if (!smp) kp = KI + (size_t)(b * SEQ + s) * 64;
            else kp = (s < PAST) ? ckidx + ((size_t)ptab[n * NPAGES + (s >> 7)] * PAGE + (s & 127)) * 64 : KI + (size_t)(NP + 4 * n + (s - PAST)) * 64;
            f32x4 kv[16];
#pragma unroll
            for (int d = 0; d < 16; ++d) kv[d] = *(const f32x4*)(kp + 4 * d);
            for (int q = 0; q < nq; ++q) {
                float sc = 0.f;
#pragma unroll
                for (int h = 0; h < 8; ++h) {
                    f32x4 a = {0.f, 0.f, 0.f, 0.f};
#pragma unroll
                    for (int d = 0; d < 16; ++d) a += *(const LAS f32x4*)(q_l + q * 512 + h * 64 + 4 * d) * kv[d];
                    const float dot = (a.x + a.y) + (a.z + a.w);
                    sc += w_l[q * 8 + h] * fmaxf(dot, 0.f);
                }
                SC[(size_t)q * 4096 + s] = sc;
            }
        }
        __syncthreads();
        for (int q = F.wave; q < nq; q += NWAVES) {
            const int N = smp ? PAST + q + 1 : 16 * qb + q + 1;
            int* sel = SEL + (size_t)(R0 + q) * TOPK; int cnt;
            if (!smp) { unsigned key[64];
#pragma unroll
                for (int j = 0; j < 64; ++j) { const int s = 64 * j + F.lane; key[j] = (s < N) ? sortable(SC[(size_t)q * 4096 + s]) : 0u; }
                cnt = select_topk<64>(key, N, F.lane, sel); }
            else { unsigned key[33];
#pragma unroll
                for (int j = 0; j < 33; ++j) { const int s = 64 * j + F.lane; key[j] = (s < N) ? sortable(SC[(size_t)q * 4096 + s]) : 0u; }
                cnt = select_topk<33>(key, N, F.lane, sel); }
            if (F.lane == 0) NSEL[R0 + q] = cnt;
        }
        __syncthreads();
    }
}

__device__ __forceinline__ void p12_attention(Frame& F) {
    const float* QR = (const float*)(F.ws + WS_QR); const float* KR = (const float*)(F.ws + WS_KR); const float* H1 = (const float*)(F.ws + WS_H);
    const int* SEL = (const int*)(F.ws + WS_SEL); const int* NSEL = (const int*)(F.ws + WS_NSEL);
    const int* ptab = (const int*)INP(8); const float* ck = INP(4); const float* cv = INP(5);
    bf16* AO = (bf16*)(F.ws + WS_AO);
    const int gw = F.vcu * NWAVES + F.wave, NGW = F.G * NWAVES, lane = F.lane;
    for (int r = gw; r < M; r += NGW) {
        const bool smp = r >= NP; const int n = (r - NP) >> 2, b = r >> 12;
        f32x4 qa = *(const f32x4*)(QR + (size_t)r * 512 + 8 * lane) * ATT_SCALE, qc = *(const f32x4*)(QR + (size_t)r * 512 + 8 * lane + 4) * ATT_SCALE;
        const int cnt = NSEL[r]; const int* sel = SEL + (size_t)r * TOPK;
        float mx = -INFINITY, ls = 0.f; f32x4 oa = {0.f, 0.f, 0.f, 0.f}, oc = oa;
        for (int i = 0; i < cnt; ++i) {
            const int s = __builtin_amdgcn_readfirstlane(sel[i]);
            const float* kp; const float* vp;
            if (!smp) { kp = KR + (size_t)(b * SEQ + s) * 512; vp = H1 + (size_t)(b * SEQ + s) * OCOLS_P + O_V; }
            else if (s < PAST) { const size_t ro = ((size_t)ptab[n * NPAGES + (s >> 7)] * PAGE + (s & 127)) * 512; kp = ck + ro; vp = cv + ro; }
            else { const int rr = NP + 4 * n + (s - PAST); kp = KR + (size_t)rr * 512; vp = H1 + (size_t)rr * OCOLS_P + O_V; }
            const f32x4 ka = *(const f32x4*)(kp + 8 * lane), kc = *(const f32x4*)(kp + 8 * lane + 4);
            const f32x4 va = *(const f32x4*)(vp + 8 * lane), vc = *(const f32x4*)(vp + 8 * lane + 4);
            const f32x4 pr = qa * ka + qc * kc;
            float lg = (pr.x + pr.y) + (pr.z + pr.w);
            lg += __shfl_xor(lg, 1); lg += __shfl_xor(lg, 2); lg += __shfl_xor(lg, 4);
            const float mn = fmaxf(mx, lg), sc = __expf(mx - mn), p = __expf(lg - mn);
            ls = ls * sc + p; oa = oa * sc + va * p; oc = oc * sc + vc * p; mx = mn;
        }
        const float il = 1.f / ls; oa = oa * il; oc = oc * il;
        *(v4u*)(AO + (size_t)r * D + 512 + 8 * lane) = (v4u){pk2(oa.x, oa.y), pk2(oa.z, oa.w), pk2(oc.x, oc.y), pk2(oc.z, oc.w)};
    }
}
constexpr int N_PHASES = 19;
struct Args { const float* in[28]; float* out; unsigned char* ws; int ph_lo, ph_hi; };
__global__ void __launch_bounds__(NTHR, 2) fwd(Args args) {
    extern __shared__ __attribute__((aligned(16))) unsigned char lds[];
    Frame F;
    F.lds = (LAS unsigned char*)lds;
    F.MISC = (volatile LAS unsigned*)(F.lds + MISC_OFF);
    F.tid = threadIdx.x; F.lane = F.tid & 63; F.wave = __builtin_amdgcn_readfirstlane(F.tid >> 6);
    F.G = gridDim.x; { const int bx = blockIdx.x; F.vcu = (F.G % 8 == 0) ? (bx % 8) * (F.G / 8) + bx / 8 : bx; }
#pragma unroll
    for (int i = 0; i < 28; ++i) F.in[i] = args.in[i];
    F.out = args.out; F.ws = args.ws;
    F.ctl = (gu32*)(F.ws + WS_CTL);
    for (int u = F.tid; u < (LDS_BYTES - LDSCTL_OFF) / 4; u += NTHR) ((LAS unsigned*)(F.lds + LDSCTL_OFF))[u] = 0u;
    __syncthreads();
    XcdBarrier bar = xcd_barrier_post((unsigned*)(F.ctl + CW_BAR), F.MISC + 8);
    const int lo = args.ph_lo, hi = args.ph_hi;
#define IN(k) (lo <= (k) && (k) < hi)
#define SEAM(k) do { if (IN(k) && IN((k) + 1)) xcd_barrier(bar); } while (0)
#define GEMM_F32(Aoff, Boff, Nn, Kk, Coff) do { pg8::Gemm g{(const pg8::bf16_t*)(F.ws + (Aoff)), (const pg8::bf16_t*)(F.ws + (Boff)), M, (Nn), (Kk)}; pg8::StaticOrder S; S.init(M, (Nn), F.G, (int)blockIdx.x); \
        pg8::EpiF32 E{(float*)(F.ws + (Coff)), (Nn)}; pg8::gemm_phase<pg8::EpiF32, pg8::StaticOrder, true, true>(F.lds, g, S, E); } while (0)

    if (IN(0)) { p0_prologue(F); } SEAM(0);
    if (IN(1)) { GEMM_F32(WS_XB0, WS_WINE, ECOLS, D, WS_H); } SEAM(1);
    if (IN(2)) { p2_mixer_even(F); } SEAM(2);
    if (IN(3)) { GEMM_F32(WS_AO, WS_WOUTE, D, D, WS_Y); } SEAM(3);
    if (IN(4)) { ln_phase(F, F.in[0], F.in[1], (const float*)(F.ws + WS_Y), F.in[20], F.in[21], (float*)(F.ws + WS_XF0), (bf16*)(F.ws + WS_XBF0)); } SEAM(4);
    if (IN(5)) { GEMM_F32(WS_XBF0, WS_WUP, DFF2, D, WS_HU); } SEAM(5);
    if (IN(6)) { conv_gate_phase(F, 0); } SEAM(6);
    if (IN(7)) { GEMM_F32(WS_G, WS_WDN, D, DFF, WS_Y); } SEAM(7);
    if (IN(8)) { const float* x1 = (const float*)(F.ws + WS_XF0); ln_phase(F, x1, x1 + (size_t)NP * D, (const float*)(F.ws + WS_Y), F.in[26], F.in[27], (float*)(F.ws + WS_XF1), (bf16*)(F.ws + WS_XBF1)); } SEAM(8);
    if (IN(9)) { GEMM_F32(WS_XBF1, WS_WINO, OCOLS_P, D, WS_H); } SEAM(9);
    if (IN(10)) { p10_post_odd(F); } SEAM(10);
    if (IN(11)) { p11_index_select(F); } SEAM(11);
    if (IN(12)) { p12_attention(F); } SEAM(12);
    if (IN(13)) { GEMM_F32(WS_AO, WS_WOUTO, D, D, WS_Y); } SEAM(13);
    if (IN(14)) { const float* x2 = (const float*)(F.ws + WS_XF1); ln_phase(F, x2, x2 + (size_t)NP * D, (const float*)(F.ws + WS_Y), F.in[20] + D, F.in[21] + D, (float*)(F.ws + WS_XF0), (bf16*)(F.ws + WS_XBF0)); } SEAM(14);
    if (IN(15)) { GEMM_F32(WS_XBF0, WS_WUP + WUP_BYTES, DFF2, D, WS_HU); } SEAM(15);
    if (IN(16)) { conv_gate_phase(F, 1); } SEAM(16);
    if (IN(17)) { GEMM_F32(WS_G, WS_WDN + WDN_BYTES, D, DFF, WS_Y); } SEAM(17);
    if (IN(18)) { const float* x3 = (const float*)(F.ws + WS_XF0); ln_phase(F, x3, x3 + (size_t)NP * D, (const float*)(F.ws + WS_Y), F.in[26] + D, F.in[27] + D, F.out + OUT_YP, (bf16*)nullptr); }
#undef IN
#undef SEAM
}

#ifndef MK_N_LAUNCHES
#define MK_N_LAUNCHES 1
#endif
extern "C" void kernel_launch(void* const* d_in, const int* in_sizes, int n_in, void* d_out, int out_size, void* d_ws, size_t ws_size, hipStream_t stream) {
    static int grid = 0;
    if (grid == 0) {
        if (n_in != 28 || out_size != (int)OUT_END || ws_size < WS_END) { fprintf(stderr, "kernel_launch: unexpected sizes: n_in %d out %d ws %zu\n", n_in, out_size, ws_size); grid = -1; return; }
        int dev = 0, cus = 0, per_cu = 0;
        if (hipGetDevice(&dev) != hipSuccess || hipDeviceGetAttribute(&cus, hipDeviceAttributeMultiprocessorCount, dev) != hipSuccess) { grid = -1; return; }
        if (hipFuncSetAttribute((const void*)fwd, hipFuncAttributeMaxDynamicSharedMemorySize, LDS_BYTES) != hipSuccess) { fprintf(stderr, "kernel_launch: hipFuncSetAttribute failed\n"); grid = -1; return; }
        if (hipOccupancyMaxActiveBlocksPerMultiprocessor(&per_cu, (const void*)fwd, NTHR, LDS_BYTES) != hipSuccess || per_cu < 1) fprintf(stderr, "kernel_launch: occupancy query reports %d\n", per_cu);
        (void)hipGetLastError();
        grid = cus;
    }
    if (grid < 0) return;
    if (hipMemsetAsync((char*)d_ws + WS_CTL, 0, CTL_ZERO_BYTES, stream) != hipSuccess) return;
    Args a{};
    for (int i = 0; i < 28; ++i) a.in[i] = (const float*)d_in[i];
    a.out = (float*)d_out; a.ws = (unsigned char*)d_ws;
#if MK_N_LAUNCHES == 1
    a.ph_lo = 0; a.ph_hi = N_PHASES;
    hipLaunchKernelGGL(fwd, dim3(grid), dim3(NTHR), LDS_BYTES, stream, a);
#else
    for (int p = 0; p < N_PHASES; ++p) { a.ph_lo = p; a.ph_hi = p + 1; hipLaunchKernelGGL(fwd, dim3(grid), dim3(NTHR), LDS_BYTES, stream, a); }
#endif
}
```

```cpp
#include <hip/hip_runtime.h>
#include <cstdio>
#include <cstdint>
namespace pg8 {
#define PG8_LAS __attribute__((address_space(3)))
typedef unsigned short bf16_t;
typedef short bf16x8 __attribute__((ext_vector_type(8)));
typedef float f32x4 __attribute__((ext_vector_type(4)));
typedef unsigned u32x4 __attribute__((ext_vector_type(4)));
constexpr int BM = 256, BK = 64, HALF = 128, HTB = HALF * BK * 2  , STAGE_BYTES = 8 * HTB, NXCD = 8, WGM = 8;

__host__ __device__ __forceinline__ int lds_byte(int r, int c) { const int st = (r >> 4) * 2 + (c >> 5), rr = r & 15, cc = c & 31, ob = rr * 64 + cc * 2; return st * 1024 + (ob ^ (((ob >> 9) & 1) << 5)); }
__host__ __device__ __forceinline__ void stage_rc(int b, int& R, int& C) { const int st = b / 1024, sb = b % 1024, swz = sb ^ (((sb >> 9) & 1) << 5); R = (st >> 1) * 16 + swz / 64; C = (st & 1) * 32 + (swz % 64) / 2; }
__host__ __device__ __forceinline__ int perm32(int rho) { const int n = rho >> 4, i = rho & 15; return 8 * (i >> 2) + 4 * n + (i & 3); }

struct Unit { int pm, pn; };
struct Gemm { const bf16_t* A; const bf16_t* Bt; int M, N, K; };

struct StaticOrder {
    int nM, nN, nwg, G, c;
    __host__ __device__ void init(int M, int N, int G_, int c_) { nM = M / BM; nN = N / BM; nwg = nM * nN; G = G_; c = c_; }
    __host__ __device__ bool next(int i, Unit& u) const {
        const long L = (long)i * G + c; if (L >= nwg) return false;
        int wgid = (int)L; { const int q = nwg / NXCD, r = nwg % NXCD, xcd = wgid % NXCD, off = wgid / NXCD; wgid = (xcd < r ? xcd * (q + 1) : r * (q + 1) + (xcd - r) * q) + off; }
        const int nig = WGM * nN, gid = wgid / nig, fm = gid * WGM, gsz = (nM - fm) < WGM ? (nM - fm) : WGM;
        u.pm = fm + ((wgid % nig) % gsz); u.pn = (wgid % nig) / gsz; return true;
    }
    __device__ __forceinline__ void a_ready(const Unit&) const {}
    __device__ __forceinline__ void done(const Unit&) const {}
};

__device__ __forceinline__ unsigned cvt_pk_bf16(float lo, float hi) { unsigned r; asm volatile("v_cvt_pk_bf16_f32 %0, %1, %2" : "=v"(r) : "v"(lo), "v"(hi)); return r; }
struct EpiF32 {
    static constexpr bool PERM = true, AFTER_DRAIN = false;
    float* C; int ldc;
    __device__ __forceinline__ void operator()(const f32x4 (&acc)[2][2][4][2], const Unit& u, int wr, int wc, int fr, int fq) const {
        const int row0 = u.pm * BM + wr * 64 + fr, col0 = u.pn * BM + wc * 32 + 8 * fq;
#pragma unroll
        for (int ai = 0; ai < 2; ++ai)
#pragma unroll
            for (int m = 0; m < 4; ++m) { float* rowp = C + (size_t)(row0 + ai * HALF + m * 16) * ldc + col0;
#pragma unroll
                for (int bj = 0; bj < 2; ++bj) { *(f32x4*)(rowp + bj * HALF) = acc[ai][bj][m][0]; *(f32x4*)(rowp + bj * HALF + 4) = acc[ai][bj][m][1]; } }
    }
};
template <class Epi, class Sched, bool ALIGN_EPI = false, bool SP2 = false>
__device__ __forceinline__ void gemm_phase(PG8_LAS unsigned char* lds, const Gemm g, const Sched& S, const Epi& E) {
    const int tid = threadIdx.x, wid = __builtin_amdgcn_readfirstlane(tid >> 6), lane = tid & 63, wr = wid >> 2, wc = wid & 3, fr = lane & 15, fq = lane >> 4;
    const int K = g.K, nt = K / BK;
    unsigned voffA[2], voffB[2];
#pragma unroll
    for (int i = 0; i < 2; ++i) { int R, C; stage_rc(tid * 16 + i * 8192, R, C); const int Rb = Epi::PERM ? ((R & ~31) + perm32(R & 31)) : R;
        voffA[i] = (unsigned)(R * K + C) * 2u; voffB[i] = (unsigned)(Rb * K + C) * 2u; }
    const size_t kstep = (size_t)(BK * 2);
    const size_t hstep = (size_t)HALF * K * 2;
    const size_t tstep = 2 * hstep;
    const unsigned ldsw = (unsigned)wid * 1024u;
    const int aoff = lds_byte(wr * 64 + fr, fq * 8), boff = lds_byte(wc * 32 + fr, fq * 8);
#define PG8_SA(b, h) (((b) * 2 + (h)) * HTB)
#define PG8_SB(b, h) ((4 + (b) * 2 + (h)) * HTB)
#define PG8_STAGE(bufoff, gbase, voff) do { _Pragma("unroll") for (int _i = 0; _i < 2; ++_i) \
        __builtin_amdgcn_global_load_lds((const unsigned*)((const char*)(gbase) + (voff)[_i]), (PG8_LAS unsigned*)(lds + (bufoff) + ldsw + _i * 8192), 16, 0, 0); } while (0)
#define PG8_LDA(dst, b, h) do { _Pragma("unroll") for (int m = 0; m < 4; ++m) _Pragma("unroll") for (int k = 0; k < 2; ++k) dst[m][k] = *(const PG8_LAS bf16x8*)(lds + PG8_SA(b, h) + aoff + m * 2048 + k * 1024); } while (0)
#define PG8_LDB(dst, b, h) do { _Pragma("unroll") for (int n = 0; n < 2; ++n) _Pragma("unroll") for (int k = 0; k < 2; ++k) dst[n][k] = *(const PG8_LAS bf16x8*)(lds + PG8_SB(b, h) + boff + n * 2048 + k * 1024); } while (0)
#define PG8_MMA(ai, bj, At, Bt) do { __builtin_amdgcn_s_setprio(1); _Pragma("unroll") for (int m = 0; m < 4; ++m) _Pragma("unroll") for (int n = 0; n < 2; ++n) _Pragma("unroll") for (int k = 0; k < 2; ++k) \
        acc[ai][bj][m][n] = __builtin_amdgcn_mfma_f32_16x16x32_bf16(Bt[n][k], At[m][k], acc[ai][bj][m][n], 0, 0, 0); __builtin_amdgcn_s_setprio(0); } while (0)
#define PG8_WAIT_V(n) asm volatile("s_waitcnt vmcnt(" #n ")" ::: "memory")
#define PG8_WAIT_L(n) asm volatile("s_waitcnt lgkmcnt(" #n ")" ::: "memory")
#define PG8_BAR __builtin_amdgcn_s_barrier()
#define PG8_SCHED __builtin_amdgcn_sched_barrier(0)
    Unit cur, nxt; int ui = 0;
    if (!S.next(0, cur)) return;
    f32x4 acc[2][2][4][2];
#pragma unroll
    for (int a = 0; a < 2; ++a)
#pragma unroll
        for (int b = 0; b < 2; ++b)
#pragma unroll
            for (int m = 0; m < 4; ++m)
#pragma unroll
                for (int n = 0; n < 2; ++n) acc[a][b][m][n] = (f32x4){0.f, 0.f, 0.f, 0.f};
    bf16x8 At[4][2], B0[2][2], B1[2][2];
    const char* cA = (const char*)g.A + (size_t)cur.pm * tstep; const char* cB = (const char*)g.Bt + (size_t)cur.pn * tstep;
    S.a_ready(cur);
    if constexpr (SP2) {
        PG8_STAGE(PG8_SB(0, 0), cB, voffB); PG8_STAGE(PG8_SB(0, 1), cB + hstep, voffB); PG8_STAGE(PG8_SA(0, 0), cA, voffA); PG8_STAGE(PG8_SA(0, 1), cA + hstep, voffA);
        if (wr == 1) PG8_BAR;
        PG8_WAIT_V(2); PG8_BAR;
        PG8_STAGE(PG8_SB(1, 0), cB + kstep, voffB); PG8_STAGE(PG8_SA(1, 0), cA + kstep, voffA); PG8_STAGE(PG8_SB(1, 1), cB + hstep + kstep, voffB);
        PG8_WAIT_V(6); PG8_BAR;
    } else {
        PG8_STAGE(PG8_SB(0, 0), cB, voffB); PG8_STAGE(PG8_SA(0, 0), cA, voffA); PG8_STAGE(PG8_SB(0, 1), cB + hstep, voffB); PG8_STAGE(PG8_SA(0, 1), cA + hstep, voffA);
        if (wr == 1) PG8_BAR;
        PG8_WAIT_V(4); PG8_BAR;
        PG8_STAGE(PG8_SB(1, 0), cB + kstep, voffB); PG8_STAGE(PG8_SA(1, 0), cA + kstep, voffA); PG8_STAGE(PG8_SB(1, 1), cB + hstep + kstep, voffB);
        PG8_WAIT_V(6); PG8_BAR;
    }
    for (;;) {
        const bool has_next = S.next(ui + 1, nxt);
        const char* nA = has_next ? (const char*)g.A + (size_t)nxt.pm * tstep : cA; const char* nB = has_next ? (const char*)g.Bt + (size_t)nxt.pn * tstep : cB;
        for (int t = 0; t < nt; t += 2) {
            const bool last = (t == nt - 2);
            const char* a1 = cA + (size_t)(t + 1) * kstep;
            const char* a2 = last ? nA : cA + (size_t)(t + 2) * kstep; const char* b2 = last ? nB : cB + (size_t)(t + 2) * kstep;
            const char* a3 = a2 + kstep; const char* b3 = b2 + kstep;
            if (last && has_next) S.a_ready(nxt);
            if constexpr (SP2) {
            PG8_LDB(B0, 0, 0); PG8_LDB(B1, 0, 1); PG8_SCHED; PG8_LDA(At, 0, 0); PG8_STAGE(PG8_SA(1, 1), a1 + hstep, voffA);
            PG8_WAIT_V(8); PG8_WAIT_L(0); PG8_BAR; PG8_MMA(0, 0, At, B0); PG8_MMA(0, 1, At, B1); PG8_BAR; PG8_SCHED;
            PG8_LDA(At, 0, 1); PG8_STAGE(PG8_SB(0, 0), b2, voffB); PG8_STAGE(PG8_SB(0, 1), b2 + hstep, voffB); PG8_STAGE(PG8_SA(0, 0), a2, voffA);
            PG8_WAIT_V(8); PG8_WAIT_L(0); PG8_BAR; PG8_MMA(1, 0, At, B0); PG8_MMA(1, 1, At, B1); PG8_BAR; PG8_SCHED;
            PG8_LDB(B0, 1, 0); PG8_LDB(B1, 1, 1); PG8_SCHED; PG8_LDA(At, 1, 0); PG8_STAGE(PG8_SA(0, 1), a2 + hstep, voffA);
            PG8_WAIT_V(8); PG8_WAIT_L(0); PG8_BAR; PG8_MMA(0, 0, At, B0); PG8_MMA(0, 1, At, B1); PG8_BAR; PG8_SCHED;
            PG8_LDA(At, 1, 1); PG8_STAGE(PG8_SB(1, 0), b3, voffB); PG8_STAGE(PG8_SB(1, 1), b3 + hstep, voffB); PG8_STAGE(PG8_SA(1, 0), a3, voffA);
            PG8_WAIT_V(8); PG8_WAIT_L(0); PG8_BAR; PG8_MMA(1, 0, At, B0); PG8_MMA(1, 1, At, B1); PG8_BAR; PG8_SCHED;
            } else {
            PG8_LDB(B0, 0, 0); PG8_SCHED; PG8_LDA(At, 0, 0); PG8_STAGE(PG8_SA(1, 1), a1 + hstep, voffA);
            PG8_WAIT_L(8); PG8_BAR; PG8_WAIT_L(0); PG8_MMA(0, 0, At, B0); PG8_BAR; PG8_SCHED;
            PG8_LDB(B1, 0, 1); PG8_STAGE(PG8_SB(0, 0), b2, voffB);
            PG8_BAR; PG8_WAIT_L(0); PG8_MMA(0, 1, At, B1); PG8_BAR;
            PG8_LDA(At, 0, 1); PG8_STAGE(PG8_SA(0, 0), a2, voffA);
            PG8_BAR; PG8_WAIT_L(0); PG8_MMA(1, 0, At, B0); PG8_BAR; PG8_SCHED;
            PG8_STAGE(PG8_SB(0, 1), b2 + hstep, voffB);
            PG8_WAIT_V(6); PG8_BAR; PG8_MMA(1, 1, At, B1); PG8_BAR;
            PG8_LDB(B0, 1, 0); PG8_SCHED; PG8_LDA(At, 1, 0); PG8_STAGE(PG8_SA(0, 1), a2 + hstep, voffA);
            PG8_WAIT_L(8); PG8_BAR; PG8_WAIT_L(0); PG8_MMA(0, 0, At, B0); PG8_BAR; PG8_SCHED;
            PG8_LDB(B1, 1, 1); PG8_STAGE(PG8_SB(1, 0), b3, voffB);
            PG8_BAR; PG8_WAIT_L(0); PG8_MMA(0, 1, At, B1); PG8_BAR;
            PG8_LDA(At, 1, 1); PG8_STAGE(PG8_SA(1, 0), a3, voffA);
            PG8_BAR; PG8_WAIT_L(0); PG8_MMA(1, 0, At, B0); PG8_BAR; PG8_SCHED;
            PG8_STAGE(PG8_SB(1, 1), b3 + hstep, voffB);
            PG8_WAIT_V(6); PG8_BAR; PG8_MMA(1, 1, At, B1); PG8_BAR;
            }
        }
        if constexpr (ALIGN_EPI) { if (wr == 0) PG8_BAR; }
        if constexpr (!Epi::AFTER_DRAIN) { E(acc, cur, wr, wc, fr, fq); S.done(cur); }
        if (!has_next) break;
#pragma unroll
        for (int a = 0; a < 2; ++a)
#pragma unroll
            for (int b = 0; b < 2; ++b)
#pragma unroll
                for (int m = 0; m < 4; ++m)
#pragma unroll
                    for (int n = 0; n < 2; ++n) acc[a][b][m][n] = (f32x4){0.f, 0.f, 0.f, 0.f};
        cur = nxt; cA = nA; cB = nB; ++ui;
        if constexpr (ALIGN_EPI) { if (wr == 1) PG8_BAR; }
    }
    PG8_WAIT_V(0);
    if constexpr (!ALIGN_EPI) { if (wr == 0) PG8_BAR; }
    PG8_BAR;
    if constexpr (Epi::AFTER_DRAIN) { E.fused(acc, cur, wr, wc, fr, fq, lds, wid, lane); S.done(cur); }
#undef PG8_SA
#undef PG8_SB
#undef PG8_STAGE
#undef PG8_LDA
#undef PG8_LDB
#undef PG8_MMA
#undef PG8_WAIT_V
#undef PG8_WAIT_L
#undef PG8_BAR
#undef PG8_SCHED
}
}
#include <hip/hip_bf16.h>
#include <cmath>
namespace attn_body {
using bf16=__hip_bfloat16;
using bf16x8=__attribute__((ext_vector_type(8)))short;
using s16x4=__attribute__((ext_vector_type(4)))short;
using f32x16=__attribute__((ext_vector_type(16)))float;
using u32x4=__attribute__((ext_vector_type(4)))unsigned;
constexpr int BATCH=4,NHEAD=8,SEQ=4096,D=64,DM=NHEAD*D,OPITCH=1024;
constexpr int NW=8,QBLK=32,QB=QBLK*NW,KVBLK=64,NQB=SEQ/QB;
constexpr int ATTN_PITCH=DM, ATTN_UNIT_ROWS=QB;
__device__ __forceinline__ int crow(int r,int hi){return (r&3)+8*(r>>2)+4*hi;}
#define SBAR() __builtin_amdgcn_sched_barrier(0)
__device__ __forceinline__ void cmask(f32x16&p0,f32x16&p1,int jb,int qrel,int hi){
  const float NEG=-INFINITY; int kb=64*jb+4*hi;
  #pragma unroll
  for(int r=0;r<16;++r){int kv=kb+(r&3)+8*(r>>2); if(kv>qrel)p0[r]=NEG; if(kv+32>qrel)p1[r]=NEG;}
}

constexpr int NSLOT=3, SLOTB=8192;
constexpr int LDS_K=0, LDS_V=NSLOT*SLOTB, LDS_WS=2*NSLOT*SLOTB, LDS_OST=LDS_WS+NW*64*4, LDS_MSK=LDS_OST+NW*4096, LDS_BYTES=LDS_MSK+NW*1024;
constexpr float C2=0.125f*1.4426950408889634f;
__device__ __forceinline__ void glds16(const void*sbase,unsigned voff,unsigned lds_dst){unsigned keep;
  asm volatile("s_mov_b32 %0, m0\n\ts_mov_b32 m0, %3\n\ts_nop 0\n\tglobal_load_lds_dwordx4 %1, %2\n\ts_mov_b32 m0, %0":"=&s"(keep):"v"(voff),"s"(sbase),"s"(lds_dst):"memory");}
__device__ __forceinline__ float max3f(float a,float b,float c){float r;asm("v_max3_f32 %0, %1, %2, %3":"=v"(r):"v"(a),"v"(b),"v"(c));return r;}
__device__ __forceinline__ float max2f(float a,float b){float r;asm("v_max_f32_e32 %0, %1, %2":"=v"(r):"v"(a),"v"(b));return r;}
__device__ __forceinline__ float fadd_s(float a,float b){float r;asm("v_add_f32_e32 %0, %1, %2":"=v"(r):"v"(a),"v"(b));return r;}
__device__ __forceinline__ float fsub_s(float a,float b){float r;asm("v_sub_f32_e32 %0, %1, %2":"=v"(r):"v"(a),"v"(b));return r;}
typedef float f32x2_t __attribute__((ext_vector_type(2))); typedef __bf16 bf16x2_t __attribute__((ext_vector_type(2)));
__device__ __forceinline__ unsigned cvtpk_s(float lo,float hi){f32x2_t v={lo,hi};bf16x2_t b=__builtin_convertvector(v,bf16x2_t);return __builtin_bit_cast(unsigned,b);}
#define WAIT_BAR(N) asm volatile("s_waitcnt vmcnt(" #N ") lgkmcnt(0)\n\ts_barrier":::"memory")

__device__ __forceinline__ void qkt(f32x16&p0,f32x16&p1,const char*Kslot,const bf16x8*qr,const f32x16&negm,int r32,int hi){
  const char*kb=Kslot+hi*1024+r32*16;
  #pragma unroll
  for(int d0=0;d0<4;++d0){
    const bf16x8 b0=*reinterpret_cast<const bf16x8*>(kb+d0*2048);
    const bf16x8 b1=*reinterpret_cast<const bf16x8*>(kb+d0*2048+512);
    if(d0==0){p0=__builtin_amdgcn_mfma_f32_32x32x16_bf16(b0,qr[0],negm,0,0,0);p1=__builtin_amdgcn_mfma_f32_32x32x16_bf16(b1,qr[0],negm,0,0,0);}
    else{p0=__builtin_amdgcn_mfma_f32_32x32x16_bf16(b0,qr[d0],p0,0,0,0);p1=__builtin_amdgcn_mfma_f32_32x32x16_bf16(b1,qr[d0],p1,0,0,0);}}
}
typedef __attribute__((address_space(3))) const char* lds_cptr;
typedef short v4i16_t __attribute__((ext_vector_type(4)));
__device__ __forceinline__ void kload8(bf16x8*kf,lds_cptr kp){
  kf[0]=*(const __attribute__((address_space(3))) bf16x8*)(kp);      kf[1]=*(const __attribute__((address_space(3))) bf16x8*)(kp+512);
  kf[2]=*(const __attribute__((address_space(3))) bf16x8*)(kp+2048); kf[3]=*(const __attribute__((address_space(3))) bf16x8*)(kp+2560);
  kf[4]=*(const __attribute__((address_space(3))) bf16x8*)(kp+4096); kf[5]=*(const __attribute__((address_space(3))) bf16x8*)(kp+4608);
  kf[6]=*(const __attribute__((address_space(3))) bf16x8*)(kp+6144); kf[7]=*(const __attribute__((address_space(3))) bf16x8*)(kp+6656);
}
__device__ __forceinline__ void kload2(bf16x8*kf,lds_cptr kp,int j){ kf[2*j]=*(const __attribute__((address_space(3))) bf16x8*)(kp+j*2048); kf[2*j+1]=*(const __attribute__((address_space(3))) bf16x8*)(kp+j*2048+512); }
__device__ __forceinline__ s16x4 vtr(lds_cptr p){ return __builtin_bit_cast(s16x4,__builtin_amdgcn_ds_read_tr16_b64_v4i16((__attribute__((address_space(3))) v4i16_t*)p)); }
__device__ __forceinline__ float rowmax(const f32x16&p0,const f32x16&p1){
  float a=max3f(p0[0],p0[1],p1[0]),b=max3f(p0[2],p0[3],p1[1]);a=max3f(a,p1[2],p1[3]);
  #pragma unroll
  for(int r=4;r<16;r+=4){a=max3f(a,p0[r],p0[r+1]);b=max3f(b,p0[r+2],p0[r+3]);a=max3f(a,p1[r],p1[r+1]);b=max3f(b,p1[r+2],p1[r+3]);}
  const float m=max2f(a,b);
  auto rr=__builtin_amdgcn_permlane32_swap(__float_as_uint(m),__float_as_uint(m),false,false);
  return max2f(__uint_as_float(rr[0]),__uint_as_float(rr[1]));
}
__device__ __forceinline__ void pv(f32x16*o,int vb,bf16x8 pa0,bf16x8 pa1,bf16x8 pa2,bf16x8 pa3){
  #pragma unroll
  for(int d0=0;d0<2;++d0){s16x4 lo[4],hi[4];
    #pragma unroll
    for(int ks=0;ks<4;++ks){
      asm volatile("ds_read_b64_tr_b16 %0,%1 offset:%c2":"=&v"(lo[ks]):"v"(vb),"i"(d0*4096+ks*1024):"memory");
      asm volatile("ds_read_b64_tr_b16 %0,%1 offset:%c2":"=&v"(hi[ks]):"v"(vb),"i"(d0*4096+ks*1024+512):"memory");}
    asm volatile("s_waitcnt lgkmcnt(0)":::"memory");SBAR();
    #define PK(k) (bf16x8){lo[k][0],lo[k][1],lo[k][2],lo[k][3],hi[k][0],hi[k][1],hi[k][2],hi[k][3]}
    o[d0]=__builtin_amdgcn_mfma_f32_32x32x16_bf16(pa0,PK(0),o[d0],0,0,0);
    o[d0]=__builtin_amdgcn_mfma_f32_32x32x16_bf16(pa1,PK(1),o[d0],0,0,0);
    o[d0]=__builtin_amdgcn_mfma_f32_32x32x16_bf16(pa2,PK(2),o[d0],0,0,0);
    o[d0]=__builtin_amdgcn_mfma_f32_32x32x16_bf16(pa3,PK(3),o[d0],0,0,0);
    #undef PK
  }
}

#ifndef ATTN_STORE16
#define ATTN_STORE16(p,v) (*(u32x4*)(p)=(v))
#endif
__device__ __forceinline__ void glds4(const void*sbase,unsigned voff,unsigned lds_dst){unsigned keep;
  asm volatile("s_mov_b32 %0, m0\n\ts_mov_b32 m0, %3\n\ts_nop 0\n\tglobal_load_lds_dword %1, %2\n\ts_mov_b32 m0, %0":"=&s"(keep):"v"(voff),"s"(sbase),"s"(lds_dst):"memory");}
__device__ __forceinline__ float mand(float e,int w,int pos){return __uint_as_float(__float_as_uint(e)&(unsigned)__builtin_amdgcn_sbfe(w,pos,1));}
template<int THRL> __device__ __forceinline__ void attn_unit(int b,int h,int qb,const bf16*Q,const bf16*__restrict__ K,const bf16*__restrict__ V,bf16*O,const unsigned long long*MK,char*shm){
  const int tid=threadIdx.x,lane=tid&63,r32=lane&31,hi=lane>>5; const int wid=__builtin_amdgcn_readfirstlane(tid>>6);
  const long rowbase=(long)b*SEQ; const int q0=qb*QB;
  const bf16*Qw=Q+(rowbase+q0+wid*QBLK)*DM+h*D;
  const bf16*Kh=K+rowbase*DM+h*D,*Vh=V+rowbase*DM+h*D;
  typedef __attribute__((address_space(3))) const char* lds_cptr0; const lds_cptr0 shm3m=(lds_cptr0)shm;
  const unsigned lds0=(unsigned)(uintptr_t)shm;
  float*wsf=(float*)(shm+LDS_WS)+wid*64;
  const unsigned koff=(unsigned)(lane*DM+wid*8)*2u;
  const unsigned voff=(unsigned)((16*(wid&3)+(lane>>2))*DM+(wid>>2)*32+(lane&3)*8)*2u;
  const unsigned kdst=lds0+LDS_K+wid*1024, vdst=lds0+LDS_V+wid*1024;
  #define DMA_K(t,slot) glds16(Kh+(long)(t)*KVBLK*DM,koff,(unsigned)__builtin_amdgcn_readfirstlane(kdst+(slot)))
  #define DMA_V(t,slot) glds16(Vh+(long)(t)*KVBLK*DM,voff,(unsigned)__builtin_amdgcn_readfirstlane(vdst+(slot)))
  const int vb0=(int)(lds0+LDS_V)+((lane>>4)&1)*32+(lane&3)*8+(4*hi+((lane&15)>>2))*64;
  const char*Kbase=shm+LDS_K; bf16x8 kf[8];
  const lds_cptr shm3=(lds_cptr)shm; const lds_cptr kp0=shm3+LDS_K+hi*1024+r32*16; const lds_cptr vp0=shm3+LDS_V+((lane>>4)&1)*32+(lane&3)*8+(4*hi+((lane&15)>>2))*64;
  const int NT=(q0+QB)/KVBLK;
  const char*mrow=(const char*)(MK+(size_t)(rowbase+q0+wid*QBLK)*64); const unsigned moff=(unsigned)r32*512u;
  const unsigned mdst=lds0+LDS_MSK+wid*1024;
  typedef __attribute__((address_space(3))) const int* lds_iptr; const lds_iptr mp=(lds_iptr)(shm3m+LDS_MSK+wid*1024)+lane;
  #define MDMA(t,slot) do{ glds4(mrow+(long)(t)*8,moff,(unsigned)__builtin_amdgcn_readfirstlane(mdst+(slot)*512)); glds4(mrow+(long)(t)*8+4,moff,(unsigned)__builtin_amdgcn_readfirstlane(mdst+(slot)*512+256)); }while(0)
  #define MRD(slot,LO,HI) const int LO=mp[(slot)*128]>>(4*hi), HI=mp[(slot)*128+64]>>(4*hi)
  #define BP(r) (((r)&3)+8*((r)>>2))
  MDMA(0,0); MDMA(1,1);
  DMA_K(0,0);DMA_V(0,0);DMA_K(1,SLOTB);
  bf16x8 qr[4];
  #pragma unroll
  for(int d0=0;d0<4;++d0)qr[d0]=*reinterpret_cast<const bf16x8*>(&Qw[(long)r32*DM+d0*16+hi*8]);
  float mhat=0.f,l_reg=0.f;f32x16 o[2];o[0]=f32x16{};o[1]=f32x16{};f32x16 negm=f32x16{};asm volatile("":"+v"(negm));
  const int qrel=wid*QBLK+r32;
  #define CMASK(P0,P1,t) do{int jb_=(t)-(NT-4); if(jb_>=0)cmask(P0,P1,jb_,qrel,hi);}while(0)
  bool resc=false;
  #define START(P0,P1) do{ const float rm=rowmax(P0,P1); resc=false; \
    { const float dl=rm; mhat=fadd_s(mhat,dl); \
      _Pragma("unroll") for(int r=0;r<16;++r){P0[r]=fsub_s(P0[r],dl);P1[r]=fsub_s(P1[r],dl);} \
      _Pragma("unroll") for(int r=0;r<16;++r)negm[r]=-mhat; asm volatile("":"+v"(negm)); } \
    _Pragma("unroll") for(int r=0;r<16;++r)P0[r]=mand(__builtin_amdgcn_exp2f(P0[r]),m0lo,BP(r)); }while(0)
  #define RESC() do{ if(resc){ asm volatile("s_waitcnt lgkmcnt(0)":::"memory"); \
      _Pragma("unroll") for(int d_=0;d_<2;++d_) _Pragma("unroll") for(int r=0;r<16;++r)o[d_][r]*=wsf[crow(r,hi)]; } }while(0)
  f32x16 pA0,pA1,pB0,pB1;
  int sl_prev=0,sl_cur=0,sl_next=SLOTB;
  #define ROT() do{sl_prev=sl_cur;sl_cur=sl_next;sl_next=(sl_next==(NSLOT-1)*SLOTB)?0:sl_next+SLOTB;}while(0)
  DMA_K(2,2*SLOTB);
  WAIT_BAR(3);
  qkt(pA0,pA1,Kbase,qr,negm,r32,hi);asm volatile("s_nop 15\n\ts_nop 7":"+v"(pA0),"+v"(pA1));CMASK(pA0,pA1,0);
  MRD(0,m0lo,m0hi);
  START(pA0,pA1);
  _Pragma("unroll") for(int r=0;r<16;++r)pA1[r]=mand(__builtin_amdgcn_exp2f(pA1[r]),m0hi,BP(r));
  WAIT_BAR(0);
  DMA_K(3,0);DMA_V(1,SLOTB);
  ROT();
  kload8(kf,kp0+sl_cur);
  WAIT_BAR(2);
  s16x4 vlo[8],vhi[8]; u32x4 pw0,pw1,pw2,pw3;
  #define PKW(P,B) cvtpk_s(P[B],P[B+1])
  #define PAF(k) __builtin_bit_cast(bf16x8,pw##k)
  #define VFR(i) (bf16x8){vlo[i][0],vlo[i][1],vlo[i][2],vlo[i][3],vhi[i][0],vhi[i][1],vhi[i][2],vhi[i][3]}
  #define PIN(x) asm volatile("":"+v"(x))
  #define MX3(a,b,c) __builtin_fmaxf(__builtin_fmaxf((a),(b)),(c))
  #define GAPA(MF,A0,A1,A2,A3,W0,W1,PW) do{ MF; sacc+=A0; sacc+=A1; sacc+=A2; sacc+=A3; PIN(sacc); W0; W1; PIN(PW); SBAR(); }while(0)
  #define EX(v) __builtin_amdgcn_exp2f(v)
  #define GAPB(MF,X,B,MW) do{ MF; X[B]=mand(EX(X[B]),(MW),BP(B)); X[B+1]=mand(EX(X[B+1]),(MW),BP(B+1)); X[B+2]=mand(EX(X[B+2]),(MW),BP(B+2)); X[B+3]=mand(EX(X[B+3]),(MW),BP(B+3)); PIN(X); SBAR(); }while(0)
  #define VRD(i) do{ vlo[i]=vtr(vp_+(((i)>>2)*4096+((i)&3)*1024)); vhi[i]=vtr(vp_+(((i)>>2)*4096+((i)&3)*1024+512)); }while(0)
  #define KRD(G,j) do{ if(G){ kload2(kf,kp0+sl_next,j); SBAR(); } }while(0)
  #define STEP(C0,C1,P0,P1,t,GK,GV,GL,MS) do{ SBAR(); MRD(MS,mlo_,mhi_); \
    const lds_cptr vp_=vp0+sl_prev; \
    VRD(0); SBAR(); float sacc=(P0[0]+P0[1]); \
    GAPA(C0=__builtin_amdgcn_mfma_f32_32x32x16_bf16(kf[0],qr[0],negm,0,0,0), P0[2],P0[3],P0[4],P0[5],     pw0[0]=PKW(P0,0), pw0[1]=PKW(P0,2), pw0); \
    VRD(4); SBAR(); GAPA(C1=__builtin_amdgcn_mfma_f32_32x32x16_bf16(kf[1],qr[0],negm,0,0,0), P0[6],P0[7],P0[8],P0[9],     pw0[2]=PKW(P0,4), pw0[3]=PKW(P0,6), pw0); \
    VRD(1); SBAR(); GAPA(C0=__builtin_amdgcn_mfma_f32_32x32x16_bf16(kf[2],qr[1],C0,0,0,0),   P0[10],P0[11],P0[12],P0[13], pw1[0]=PKW(P0,8), pw1[1]=PKW(P0,10), pw1); \
    VRD(5); SBAR(); GAPA(C1=__builtin_amdgcn_mfma_f32_32x32x16_bf16(kf[3],qr[1],C1,0,0,0),   P0[14],P0[15],P1[0],P1[1],   pw1[2]=PKW(P0,12),pw1[3]=PKW(P0,14), pw1); \
    VRD(2); SBAR(); GAPA(C0=__builtin_amdgcn_mfma_f32_32x32x16_bf16(kf[4],qr[2],C0,0,0,0),   P1[2],P1[3],P1[4],P1[5],     pw2[0]=PKW(P1,0), pw2[1]=PKW(P1,2), pw2); \
    VRD(6); SBAR(); GAPA(C1=__builtin_amdgcn_mfma_f32_32x32x16_bf16(kf[5],qr[2],C1,0,0,0),   P1[6],P1[7],P1[8],P1[9],     pw2[2]=PKW(P1,4), pw2[3]=PKW(P1,6), pw2); \
    VRD(3); SBAR(); GAPA(C0=__builtin_amdgcn_mfma_f32_32x32x16_bf16(kf[6],qr[3],C0,0,0,0),   P1[10],P1[11],P1[12],P1[13], pw3[0]=PKW(P1,8), pw3[1]=PKW(P1,10), pw3); \
    VRD(7); SBAR(); GAPA(C1=__builtin_amdgcn_mfma_f32_32x32x16_bf16(kf[7],qr[3],C1,0,0,0),   P1[14],P1[15],0.f,0.f,       pw3[2]=PKW(P1,12),pw3[3]=PKW(P1,14), pw3); \
    l_reg+=sacc; \
    if(GV){MDMA((t)+1,1-(MS));} if(GK){DMA_K((t)+3,sl_cur);} if(GV){DMA_V((t)+1,sl_next);} \
    CMASK(C0,C1,t); \
    { float a=MX3(C0[0],C0[1],C1[0]),b=MX3(C0[2],C0[3],C1[1]); a=MX3(a,C1[2],C1[3]); \
      _Pragma("unroll") for(int r=4;r<16;r+=4){a=MX3(a,C0[r],C0[r+1]);b=MX3(b,C0[r+2],C0[r+3]);a=MX3(a,C1[r],C1[r+1]);b=MX3(b,C1[r+2],C1[r+3]);} \
      float rm=__builtin_fmaxf(a,b); { auto rr=__builtin_amdgcn_permlane32_swap(__float_as_uint(rm),__float_as_uint(rm),false,false); rm=__builtin_fmaxf(__uint_as_float(rr[0]),__uint_as_float(rr[1])); } \
      resc=false; \
      if(__builtin_expect(__any(rm>(float)THRL),0)){ const float dl=__builtin_fmaxf(rm,0.f); mhat+=dl; \
        _Pragma("unroll") for(int r=0;r<16;++r){C0[r]-=dl;C1[r]-=dl;} \
        _Pragma("unroll") for(int r=0;r<16;++r)negm[r]=-mhat; asm volatile("":"+v"(negm)); \
        const float f=__builtin_amdgcn_exp2f(-dl); l_reg*=f; if(hi==0)wsf[r32]=f; resc=true; } } \
    SBAR(); \
    GAPB(o[0]=__builtin_amdgcn_mfma_f32_32x32x16_bf16(PAF(0),VFR(0),o[0],0,0,0), C0,0,mlo_); \
    GAPB(o[1]=__builtin_amdgcn_mfma_f32_32x32x16_bf16(PAF(0),VFR(4),o[1],0,0,0), C0,4,mlo_); \
    KRD(GL,0); GAPB(o[0]=__builtin_amdgcn_mfma_f32_32x32x16_bf16(PAF(1),VFR(1),o[0],0,0,0), C0,8,mlo_); \
    KRD(GL,1); GAPB(o[1]=__builtin_amdgcn_mfma_f32_32x32x16_bf16(PAF(1),VFR(5),o[1],0,0,0), C0,12,mlo_); \
    KRD(GL,2); GAPB(o[0]=__builtin_amdgcn_mfma_f32_32x32x16_bf16(PAF(2),VFR(2),o[0],0,0,0), C1,0,mhi_); \
    KRD(GL,3); GAPB(o[1]=__builtin_amdgcn_mfma_f32_32x32x16_bf16(PAF(2),VFR(6),o[1],0,0,0), C1,4,mhi_); \
    GAPB(o[0]=__builtin_amdgcn_mfma_f32_32x32x16_bf16(PAF(3),VFR(3),o[0],0,0,0), C1,8,mhi_); \
    GAPB(o[1]=__builtin_amdgcn_mfma_f32_32x32x16_bf16(PAF(3),VFR(7),o[1],0,0,0), C1,12,mhi_); \
    }while(0)
  int t=1;
  #undef CMASK
  #define CMASK(P0,P1,t) do{}while(0)
  for(;t+5<NT;t+=2){
    STEP(pB0,pB1,pA0,pA1,t,true,true,true,1);     WAIT_BAR(2); RESC(); ROT();
    STEP(pA0,pA1,pB0,pB1,t+1,true,true,true,0);   WAIT_BAR(2); RESC(); ROT();
  }
  #undef CMASK
  #define CMASK(P0,P1,t) do{int jb_=(t)-(NT-4); if(jb_>=0)cmask(P0,P1,jb_,qrel,hi);}while(0)
  #define ENDW(tt) do{ if((tt)+3<NT){WAIT_BAR(2);} else if((tt)+2<NT){WAIT_BAR(1);} else {WAIT_BAR(0);} }while(0)
  for(;t+1<NT;t+=2){
    STEP(pB0,pB1,pA0,pA1,t,(t+3<NT),(t+1<NT),(t+1<NT),1);       ENDW(t);   RESC(); ROT();
    STEP(pA0,pA1,pB0,pB1,t+1,(t+4<NT),(t+2<NT),(t+2<NT),0);     ENDW(t+1); RESC(); ROT();
  }
  STEP(pB0,pB1,pA0,pA1,NT-1,false,false,false,1); RESC();
  { float sacc=pB0[0]+pB0[1]; _Pragma("unroll") for(int r=2;r<16;++r)sacc+=pB0[r]; _Pragma("unroll") for(int r=0;r<16;++r)sacc+=pB1[r]; l_reg+=sacc;
    pw0=(u32x4){PKW(pB0,0),PKW(pB0,2),PKW(pB0,4),PKW(pB0,6)};pw1=(u32x4){PKW(pB0,8),PKW(pB0,10),PKW(pB0,12),PKW(pB0,14)};pw2=(u32x4){PKW(pB1,0),PKW(pB1,2),PKW(pB1,4),PKW(pB1,6)};pw3=(u32x4){PKW(pB1,8),PKW(pB1,10),PKW(pB1,12),PKW(pB1,14)};
    SBAR(); pv(o,vb0+sl_cur,PAF(0),PAF(1),PAF(2),PAF(3)); }
  #undef PKW
  #undef PAF
  #undef VFR
  #undef PIN
  #undef MX3
  #undef GAPA
  #undef GAPB
  #undef EX
  #undef VRD
  #undef KRD
  #undef STEP
  #undef ENDW
  {auto rr=__builtin_amdgcn_permlane32_swap(__float_as_uint(l_reg),__float_as_uint(l_reg),false,false);l_reg=__uint_as_float(rr[0])+__uint_as_float(rr[1]);}
  if(hi==0)wsf[32+r32]=l_reg;asm volatile("s_waitcnt lgkmcnt(0)":::"memory");
  float rli[16];
  #pragma unroll
  for(int r=0;r<16;++r)rli[r]=__builtin_amdgcn_rcpf(wsf[32+crow(r,hi)]);
  bf16*Ow=O+(rowbase+q0+wid*QBLK)*OPITCH+h*D;
  { bf16*stg=(bf16*)(shm+LDS_OST)+wid*2048;
    #pragma unroll
    for(int r=0;r<16;++r){const int orow=crow(r,hi);
      #pragma unroll
      for(int d0=0;d0<2;++d0)stg[orow*64+d0*32+r32]=__float2bfloat16(o[d0][r]*rli[r]);}
    asm volatile("s_waitcnt lgkmcnt(0)":::"memory");
    #pragma unroll
    for(int i=0;i<4;++i){const int row=i*8+(lane>>3),ch=lane&7; const u32x4 v=*(const u32x4*)(stg+row*64+ch*8); ATTN_STORE16(Ow+(long)row*OPITCH+ch*8,v);} }
  asm volatile("s_waitcnt lgkmcnt(0)\n\ts_barrier":::"memory");
  #undef DMA_K
  #undef DMA_V
  #undef CMASK
  #undef START
  #undef RESC
  #undef ROT
  #undef MDMA
  #undef MRD
  #undef BP
}
constexpr int ATTN_LDS_BYTES=LDS_BYTES;
struct AttnTensors { const bf16* Q; const bf16* K; const bf16* V; bf16* O; const unsigned long long* MK; };
struct AttnUnit { int bh; int qb; };
struct StaticOrder {
  int vcu, G;
  __device__ __forceinline__ explicit StaticOrder(int grid,int v):vcu(v),G(grid){}
  __device__ __forceinline__ bool next(int i,AttnUnit&u)const{ const int p=vcu+(i>>1)*G; if(p>=256)return false; const int s=p&7; u.bh=p>>3; u.qb=(i&1)?15-s:s; return true; }
  __device__ __forceinline__ void a_ready(const AttnUnit&)const{}
  __device__ __forceinline__ void done(const AttnUnit&)const{}
};
template<class Sched,int THRL=8> __device__ __forceinline__ void attn_phase(char*lds,const AttnTensors&T,const Sched&S){
  AttnUnit u;
  for(int i=0;S.next(i,u);++i){ S.a_ready(u); attn_unit<THRL>(u.bh/NHEAD,u.bh%NHEAD,u.qb,T.Q,T.K,T.V,T.O,T.MK,lds); S.done(u); }
}
#undef SBAR
#undef WAIT_BAR
}
constexpr int NWAVES = 8, NTHR = 512;
constexpr int NP = 16384, NSR = 512, M = NP + NSR;
constexpr int D = 1024, SEQ = 4096, NB = 4, NSQ = 128, TS = 4, PAST = 2048, PAGE = 128, NPAGES = 16;
constexpr int DFF = 2816, DFF2 = 5632, ECOLS = 2560, OCOLS = 2632, OCOLS_P = 2816, AW = 512, TOPK = 256;
constexpr float ALPHA = 1.4142135623730951f, LN_EPS = 1e-5f, ATT_SCALE = 0.125f;
constexpr int E_U = 0, E_V = 512, E_B = 1024, E_C = 1536, E_H = 2048;
constexpr int O_P = 0, O_Q = 512, O_K = 1024, O_V = 1536, O_QI = 2048, O_KI = 2560, O_WI = 2624;
constexpr size_t OUT_YP = 0, OUT_YS = OUT_YP + (size_t)NP * D, OUT_AV = OUT_YS + (size_t)NSR * D, OUT_BP = OUT_AV + (size_t)NSR * AW,
    OUT_BS = OUT_BP + (size_t)NB * 2 * 512, OUT_CP = OUT_BS + (size_t)NSQ * 2 * 512, OUT_CS = OUT_CP + (size_t)NB * 15 * 512, OUT_KP = OUT_CS + (size_t)NSQ * 15 * 512,
    OUT_VP = OUT_KP + (size_t)NP * 512, OUT_KIP = OUT_VP + (size_t)NP * 512, OUT_KS = OUT_KIP + (size_t)NP * 64, OUT_VS = OUT_KS + (size_t)NSR * 512,
    OUT_KIS = OUT_VS + (size_t)NSR * 512, OUT_FP = OUT_KIS + (size_t)NSR * 64, OUT_FS = OUT_FP + (size_t)2 * NB * 2 * DFF2, OUT_END = OUT_FS + (size_t)2 * NSQ * 2 * DFF2;
static_assert(OUT_END == 40069120, "output size");
constexpr size_t MiB = 1u << 20;
constexpr size_t WS_CTL = 0, CTL_ZERO_BYTES = 1 * MiB;
constexpr size_t WS_ROPE = 1 * MiB;
constexpr size_t WS_WINE = 2 * MiB, WS_WOUTE = 7 * MiB, WS_WINO = 9 * MiB, WS_WOUTO = 15 * MiB, WS_WUP = 17 * MiB, WS_WDN = 39 * MiB;
constexpr size_t WUP_BYTES = (size_t)DFF2 * D * 2, WDN_BYTES = (size_t)D * DFF * 2;
static_assert(WS_WUP + 2 * WUP_BYTES <= WS_WDN && WS_WDN + 2 * WDN_BYTES <= 52 * MiB, "weights");
constexpr size_t WS_XB0 = 64 * MiB;
constexpr size_t WS_XF0 = 128 * MiB, WS_XF1 = 196 * MiB;
constexpr size_t WS_XBF0 = 264 * MiB, WS_XBF1 = 298 * MiB;
constexpr size_t WS_H = 512 * MiB;
constexpr size_t WS_AO = 704 * MiB;
constexpr size_t WS_Y = 768 * MiB;
constexpr size_t WS_HU = 1024 * MiB;
constexpr size_t WS_G = 1408 * MiB;
constexpr size_t WS_QR = 1536 * MiB, WS_KR = 1570 * MiB, WS_QI = 1604 * MiB, WS_KI = 1638 * MiB;
constexpr size_t WS_SEL = 1680 * MiB, WS_NSEL = 1698 * MiB;
constexpr size_t WS_SC = 1700 * MiB;
constexpr size_t WS_QB = 1770 * MiB, WS_KB = 1788 * MiB, WS_VB = 1806 * MiB, WS_QIB = 1824 * MiB, WS_KIB = 1842 * MiB;
constexpr size_t WS_MASK = 1846 * MiB;
constexpr size_t WS_END = 1856 * MiB;
constexpr int CW_BAR = 4096;
constexpr int RING_BYTES = 135168, LDSCTL_OFF = RING_BYTES, MISC_OFF = LDSCTL_OFF + 320, ITAB_OFF = LDSCTL_OFF + 512, LDS_BYTES = 147456;

#define GAS __attribute__((address_space(1)))
#define LAS __attribute__((address_space(3)))
typedef unsigned short bf16;
typedef unsigned v4u __attribute__((ext_vector_type(4)));
typedef unsigned v2u __attribute__((ext_vector_type(2)));
typedef float f32x4 __attribute__((ext_vector_type(4)));
typedef GAS unsigned gu32;
#define RLX_AGENT __ATOMIC_RELAXED, __HIP_MEMORY_SCOPE_AGENT
#define LDS_WAIT() asm volatile("s_waitcnt lgkmcnt(0)" ::: "memory")
#define VM_WAIT() asm volatile("s_waitcnt vmcnt(0)" ::: "memory")
__device__ __forceinline__ unsigned f2bf(float f) { unsigned u = __builtin_bit_cast(unsigned, f); return (u + 0x7fffu + ((u >> 16) & 1u)) >> 16; }
__device__ __forceinline__ unsigned pk2(float lo, float hi) { return f2bf(lo) | (f2bf(hi) << 16); }
__device__ __forceinline__ float gelu_t(float x) { const float t = x * (1.f + 0.044715f * x * x); const float e = __builtin_amdgcn_exp2f(-2.302208198f * t); return x / (1.f + e); }
__device__ __forceinline__ float silu_f(float x) { const float e = __builtin_amdgcn_exp2f(-1.4426950408889634f * x); return x / (1.f + e); }
__device__ __forceinline__ float wave_sum(float v) {
#pragma unroll
    for (int o = 1; o < 64; o <<= 1) v += __shfl_xor(v, o);
    return v;
}
#define XB_TMO      128
#define XB_XCNT(j)  (256  + 64 * (j))
#define XB_XSUB(j)  (1280 + 64 * (j))
#define XB_XGEN(j)  (2304 + 64 * (j))
#define XB_TOP      3328
#define XB_TOPGEN   3392
#define XCD_BAR_WORDS 3456
#define XB_SPIN_CAP (1u << 18)

__device__ __forceinline__ unsigned xb_ld(unsigned* p)              { return __hip_atomic_load(p, __ATOMIC_RELAXED, __HIP_MEMORY_SCOPE_AGENT); }
__device__ __forceinline__ unsigned xb_add(unsigned* p, unsigned v) { return __hip_atomic_fetch_add(p, v, __ATOMIC_RELAXED, __HIP_MEMORY_SCOPE_AGENT); }
__device__ __forceinline__ unsigned xb_xcc_id() { return (unsigned)__builtin_amdgcn_s_getreg((3 << 11) | 20) & 0xFu; }
#define XB_SPIN(cond, bar) do { unsigned _sp = 0; while (cond) { __builtin_amdgcn_s_sleep(1); \
    if ((++_sp & 255u) == 0u) { if (xb_ld(&(bar)[XB_TMO])) break; if (_sp > XB_SPIN_CAP) { atomicAdd(&(bar)[XB_TMO], 1u); break; } } } } while (0)

struct XcdBarrier {
    unsigned* bar; unsigned x;
    volatile LAS unsigned* st;
};

__device__ __forceinline__ XcdBarrier xcd_barrier_post(unsigned* bar, volatile LAS unsigned* st) {
    XcdBarrier b; b.bar = bar; b.x = xb_xcc_id(); b.st = st;
    if (threadIdx.x == 0) (void)xb_add(&bar[XB_XCNT(b.x)], 1u);
    return b;
}
__device__ __forceinline__ void xcd_barrier_complete(unsigned* bar, unsigned x, unsigned& nloc, unsigned& nx) {
    const unsigned G = gridDim.x * gridDim.y * gridDim.z;
    unsigned sum, cnt, mine, sp = 0u;
    for (;;) {
        sum = 0u; cnt = 0u; mine = 0u;
#pragma unroll
        for (unsigned j = 0; j < 16; ++j) { const unsigned c = xb_ld(&bar[XB_XCNT(j)]); sum += c; cnt += (c > 0u) ? 1u : 0u; mine = (j == x) ? c : mine; }
        if (sum == G) break;
        __builtin_amdgcn_s_sleep(1);
        if ((++sp & 255u) == 0u) { if (xb_ld(&bar[XB_TMO])) break; if (sp > XB_SPIN_CAP) { atomicAdd(&bar[XB_TMO], 1u); break; } }
    }
    nloc = mine > 0u ? mine : 1u; nx = cnt > 0u ? cnt : 1u;
}

__device__ __forceinline__ void xcd_barrier(const XcdBarrier& b) {
    asm volatile("s_waitcnt vmcnt(0)" ::: "memory");
    __syncthreads();
    if (threadIdx.x == 0) {
        unsigned* bar = b.bar;
        __builtin_amdgcn_s_waitcnt(0);
        unsigned nloc = b.st[0], nx = b.st[1];
        if (nloc == 0u) { xcd_barrier_complete(bar, b.x, nloc, nx); b.st[0] = nloc; b.st[1] = nx; }
        const unsigned old = xb_add(&bar[XB_XSUB(b.x)], 1u);
        const unsigned gen = old / nloc;
        if (old + 1u == (gen + 1u) * nloc) {
            __builtin_amdgcn_fence(__ATOMIC_RELEASE, "agent");
            asm volatile("s_waitcnt vmcnt(0)" ::: "memory");
            const unsigned og = xb_add(&bar[XB_TOP], 1u);
            const unsigned tg = og / nx;
            if (og + 1u == (tg + 1u) * nx) xb_add(&bar[XB_TOPGEN], 1u);
            else XB_SPIN(xb_ld(&bar[XB_TOPGEN]) == tg, bar);
            __builtin_amdgcn_fence(__ATOMIC_ACQUIRE, "agent");
            xb_add(&bar[XB_XGEN(b.x)], 1u);
            asm volatile("s_waitcnt vmcnt(0)" ::: "memory");
        } else {
            XB_SPIN(xb_ld(&bar[XB_XGEN(b.x)]) == gen, bar);
            __builtin_amdgcn_fence(__ATOMIC_ACQUIRE, "agent");
            asm volatile("s_waitcnt vmcnt(0)" ::: "memory");
        }
    }
    __syncthreads();
}
struct Frame {
    LAS unsigned char* lds;
    volatile LAS unsigned* MISC;
    gu32* ctl;
    int tid, lane, wave, vcu, G;
    const LAS unsigned long long* itab;
    float* out; unsigned char* ws;
};
__device__ __forceinline__ const float* inp_ptr(const Frame& F, int i) { const unsigned long long v = F.itab[i]; const unsigned lo = __builtin_amdgcn_readfirstlane((unsigned)v), hi = __builtin_amdgcn_readfirstlane((unsigned)(v >> 32)); return (const float*)(((unsigned long long)hi << 32) | lo); }
#define INP(i) inp_ptr(F, (i))
__device__ __forceinline__ const float* xrow_in(const Frame& F, int r) { return r < NP ? INP(0) + (size_t)r * D : INP(1) + (size_t)(r - NP) * D; }

__device__ __forceinline__ void p0_transpose_item(const float* W, int K, int N, int nblk, bf16* WT, LAS float* scr, int item, int lane) {
    const int kb = item / nblk, nb = item % nblk, k0 = 64 * kb, n0 = 32 * nb;
    const int nn = n0 + (lane & 31);
#pragma unroll 8
    for (int i = 0; i < 32; ++i) { const int kk = 2 * i + (lane >> 5); scr[kk * 33 + (lane & 31)] = (nn < N) ? W[(size_t)(k0 + kk) * N + nn] : 0.f; }
    LDS_WAIT(); asm volatile("" ::: "memory");
    const int c = lane & 7;
#pragma unroll
    for (int j = 0; j < 4; ++j) { const int n = (lane >> 3) + 8 * j; const LAS float* s = scr + (8 * c) * 33 + n;
        v4u o; o.x = pk2(s[0 * 33], s[1 * 33]); o.y = pk2(s[2 * 33], s[3 * 33]); o.z = pk2(s[4 * 33], s[5 * 33]); o.w = pk2(s[6 * 33], s[7 * 33]);
        *(GAS v4u*)(WT + (size_t)(n0 + n) * K + k0 + 8 * c) = o; }
    LDS_WAIT(); asm volatile("" ::: "memory");
}
__device__ __forceinline__ void p0_prologue(Frame& F) {
    LAS float* scr = (LAS float*)(F.lds + F.wave * 16384);
    const int gw = F.vcu * NWAVES + F.wave, NGW = F.G * NWAVES;
    constexpr int I_INE = 16 * 80, I_SQ = 16 * 32, I_INO = 16 * 88, I_UP = 16 * 176, I_DN = 44 * 32;
    constexpr int NITEMS = I_INE + I_SQ + I_INO + I_SQ + 2 * I_UP + 2 * I_DN;
    for (int it = gw; it < NITEMS; it += NGW) {
        int r = it;
        if (r < I_INE) { p0_transpose_item(INP(9), D, ECOLS, 80, (bf16*)(F.ws + WS_WINE), scr, r, F.lane); continue; } r -= I_INE;
        if (r < I_SQ) { p0_transpose_item(INP(15), D, D, 32, (bf16*)(F.ws + WS_WOUTE), scr, r, F.lane); continue; } r -= I_SQ;
        if (r < I_INO) { p0_transpose_item(INP(16), D, OCOLS, 88, (bf16*)(F.ws + WS_WINO), scr, r, F.lane); continue; } r -= I_INO;
        if (r < I_SQ) { p0_transpose_item(INP(19), D, D, 32, (bf16*)(F.ws + WS_WOUTO), scr, r, F.lane); continue; } r -= I_SQ;
        if (r < 2 * I_UP) { const int l = r / I_UP; p0_transpose_item(INP(22) + (size_t)l * D * DFF2, D, DFF2, 176, (bf16*)(F.ws + WS_WUP + l * WUP_BYTES), scr, r % I_UP, F.lane); continue; } r -= 2 * I_UP;
        { const int l = r / I_DN; p0_transpose_item(INP(25) + (size_t)l * DFF * D, DFF, D, 32, (bf16*)(F.ws + WS_WDN + l * WDN_BYTES), scr, r % I_DN, F.lane); }
    }
    bf16* XB = (bf16*)(F.ws + WS_XB0);
    for (int r = gw; r < M; r += NGW) {
        const f32x4* xr = (const f32x4*)xrow_in(F, r) + F.lane;
        unsigned long long* o8 = (unsigned long long*)(XB + (size_t)r * D) + F.lane;
#pragma unroll
        for (int j = 0; j < 4; ++j) { const f32x4 v = xr[64 * j]; o8[64 * j] = (unsigned long long)pk2(v.x, v.y) | ((unsigned long long)pk2(v.z, v.w) << 32); }
    }
    {
        float* ct = (float*)(F.ws + WS_ROPE); float* st = ct + 4096 * 8;
        const int gt = F.vcu * NTHR + F.tid;
        if (gt < 4096 * 8) {
            const int pos = gt >> 3, i = gt & 7;
            const float invs[8] = {1.0f, 0.1939227432012558f, 0.03760603070259094f, 0.007292664609849453f, 0.0014142135623842478f, 0.00027424818836152554f, 5.318296098266728e-05f, 1.0313386155758053e-05f};
            float inv = invs[0];
#pragma unroll
            for (int k = 1; k < 8; ++k) inv = (i == k) ? invs[k] : inv;
            const float angf = (float)pos * inv;
            const double a = (double)angf;
            const double n = __builtin_rint(a * 0.15915494309189535);
            double x = __builtin_fma(-n, 6.283185307179586, a); x = __builtin_fma(-n, 2.4492935982947064e-16, x);
            const double x2 = x * x;
            double sn = 1.0 / 51090942171709440000.0;
            sn = sn * x2 - 1.0 / 121645100408832000.0; sn = sn * x2 + 1.0 / 355687428096000.0; sn = sn * x2 - 1.0 / 1307674368000.0; sn = sn * x2 + 1.0 / 6227020800.0;
            sn = sn * x2 - 1.0 / 39916800.0; sn = sn * x2 + 1.0 / 362880.0; sn = sn * x2 - 1.0 / 5040.0; sn = sn * x2 + 1.0 / 120.0; sn = sn * x2 - 1.0 / 6.0; sn = sn * x2 + 1.0; sn = sn * x;
            double cs = 1.0 / 2432902008176640000.0;
            cs = cs * x2 - 1.0 / 6402373705728000.0; cs = cs * x2 + 1.0 / 20922789888000.0; cs = cs * x2 - 1.0 / 87178291200.0; cs = cs * x2 + 1.0 / 479001600.0;
            cs = cs * x2 - 1.0 / 3628800.0; cs = cs * x2 + 1.0 / 40320.0; cs = cs * x2 - 1.0 / 720.0; cs = cs * x2 + 1.0 / 24.0; cs = cs * x2 - 0.5; cs = cs * x2 + 1.0;
            ct[gt] = (float)cs; st[gt] = (float)sn;
        }
    }
}

__device__ __forceinline__ void ln_phase(Frame& F, const float* resP, const float* resS, const float* Y, const float* g, const float* b, float* outF, bf16* outB) {
    const int gw = F.vcu * NWAVES + F.wave, NGW = F.G * NWAVES;
    f32x4 gv[4], bv[4];
#pragma unroll
    for (int j = 0; j < 4; ++j) { gv[j] = *((const f32x4*)g + F.lane + 64 * j); bv[j] = *((const f32x4*)b + F.lane + 64 * j); }
    for (int r = gw; r < M; r += NGW) {
        const f32x4* rr = (const f32x4*)(r < NP ? resP + (size_t)r * D : resS + (size_t)(r - NP) * D) + F.lane;
        const f32x4* yr = (const f32x4*)(Y + (size_t)r * D) + F.lane;
        f32x4 v[4]; float s = 0.f;
#pragma unroll
        for (int j = 0; j < 4; ++j) { v[j] = rr[64 * j] * ALPHA + yr[64 * j]; s += (v[j].x + v[j].y) + (v[j].z + v[j].w); }
        const float mean = wave_sum(s) * (1.f / D); float s2 = 0.f;
#pragma unroll
        for (int j = 0; j < 4; ++j) { v[j] = v[j] - mean; s2 += (v[j].x * v[j].x + v[j].y * v[j].y) + (v[j].z * v[j].z + v[j].w * v[j].w); }
        const float rstd = 1.f / sqrtf(wave_sum(s2) * (1.f / D) + LN_EPS);
        f32x4* of = (f32x4*)(outF + (size_t)r * D) + F.lane;
#pragma unroll
        for (int j = 0; j < 4; ++j) { v[j] = v[j] * rstd * gv[j] + bv[j]; of[64 * j] = v[j]; }
        if (outB) { unsigned long long* o8 = (unsigned long long*)(outB + (size_t)r * D) + F.lane;
#pragma unroll
            for (int j = 0; j < 4; ++j) o8[64 * j] = (unsigned long long)pk2(v[j].x, v[j].y) | ((unsigned long long)pk2(v[j].z, v[j].w) << 32); }
    }
}
__device__ __forceinline__ void p2_mixer_even(Frame& F) {
    const float* H0 = (const float*)(F.ws + WS_H);
    bf16* AO = (bf16*)(F.ws + WS_AO);
    const float* a_g = INP(10); const float* a_b = INP(11); const float* a_ws = INP(12); const float* a_bs = INP(13); const float* bcw = INP(14);
    LAS float* Vn = (LAS float*)F.lds;
    for (int u = F.vcu; u < 512 + NSQ; u += F.G) {
        if (u < 512) {
            const int g = u & 3, chunk = (u >> 2) & 31, b = u >> 7, R0 = b * SEQ + chunk * 128;
#pragma unroll 2
            for (int i = 0; i < 16; ++i) {
                const int s = F.wave * 16 + i; const float* hp = H0 + (size_t)(R0 + s) * ECOLS + E_V + 8 * F.lane;
                const f32x4 a = *(const f32x4*)hp, c = *(const f32x4*)(hp + 4);
                float x[8] = {gelu_t(a.x), gelu_t(a.y), gelu_t(a.z), gelu_t(a.w), gelu_t(c.x), gelu_t(c.y), gelu_t(c.z), gelu_t(c.w)};
                float sm = 0.f;
#pragma unroll
                for (int k = 0; k < 8; ++k) sm += x[k];
                const float mean = wave_sum(sm) * (1.f / AW); float s2 = 0.f;
#pragma unroll
                for (int k = 0; k < 8; ++k) { x[k] -= mean; s2 += x[k] * x[k]; }
                const float rstd = 1.f / sqrtf(wave_sum(s2) * (1.f / AW) + LN_EPS);
                if ((F.lane >> 4) == g) {
                    const int c0 = 8 * F.lane;
#pragma unroll
                    for (int k = 0; k < 8; ++k) Vn[s * 132 + (c0 - 128 * g) + k] = x[k] * rstd * a_g[c0 + k] + a_b[c0 + k];
                }
            }
            __syncthreads();
            const int c4 = F.tid & 31, col = g * 128 + 4 * c4;
            const f32x4 w0 = *(const f32x4*)(bcw + col), w1 = *(const f32x4*)(bcw + 512 + col), w2 = *(const f32x4*)(bcw + 1024 + col);
            for (int i = 0; i < 8; ++i) {
                const int t = (F.tid >> 5) + 16 * i; const size_t r = (size_t)(R0 + t);
                const float* wrow = a_ws + (size_t)(g * 128 + t) * 128;
                f32x4 acc = {0.f, 0.f, 0.f, 0.f};
                for (int s = 0; s <= t; ++s) { const float w = wrow[s]; const f32x4 v = *(const LAS f32x4*)(Vn + s * 132 + 4 * c4); acc += v * w; }
                const float bs = a_bs[g * 128 + t];
                const f32x4 uu = *(const f32x4*)(H0 + r * ECOLS + E_U + col);
                const float o0 = gelu_t(uu.x) * (acc.x + bs), o1 = gelu_t(uu.y) * (acc.y + bs), o2 = gelu_t(uu.z) * (acc.z + bs), o3 = gelu_t(uu.w) * (acc.w + bs);
                *(v2u*)(AO + r * D + col) = (v2u){pk2(o0, o1), pk2(o2, o3)};
                const int tt = chunk * 128 + t;
                const f32x4 p0 = *(const f32x4*)(H0 + r * ECOLS + E_C + col) * *(const f32x4*)(H0 + r * ECOLS + E_H + col);
                f32x4 p1 = {0.f, 0.f, 0.f, 0.f}, p2 = {0.f, 0.f, 0.f, 0.f};
                if (tt >= 1) p1 = *(const f32x4*)(H0 + (r - 1) * ECOLS + E_C + col) * *(const f32x4*)(H0 + (r - 1) * ECOLS + E_H + col);
                if (tt >= 2) p2 = *(const f32x4*)(H0 + (r - 2) * ECOLS + E_C + col) * *(const f32x4*)(H0 + (r - 2) * ECOLS + E_H + col);
                const f32x4 cv = w2 * p0 + w1 * p1 + w0 * p2;
                const f32x4 bo = *(const f32x4*)(H0 + r * ECOLS + E_B + col) * cv;
                *(v2u*)(AO + r * D + 512 + col) = (v2u){pk2(bo.x, bo.y), pk2(bo.z, bo.w)};
                if (tt >= SEQ - 2) *(f32x4*)(F.out + OUT_BP + (size_t)(b * 2 + (tt - (SEQ - 2))) * 512 + col) = p0;
            }
            __syncthreads();
        } else {
            const int n = u - 512, R0 = NP + 4 * n;
            if (F.wave < 4) {
                const int t = F.wave; const float* hp = H0 + (size_t)(R0 + t) * ECOLS + E_V + 8 * F.lane;
                const f32x4 a = *(const f32x4*)hp, c = *(const f32x4*)(hp + 4);
                float x[8] = {gelu_t(a.x), gelu_t(a.y), gelu_t(a.z), gelu_t(a.w), gelu_t(c.x), gelu_t(c.y), gelu_t(c.z), gelu_t(c.w)};
                float sm = 0.f;
#pragma unroll
                for (int k = 0; k < 8; ++k) sm += x[k];
                const float mean = wave_sum(sm) * (1.f / AW); float s2 = 0.f;
#pragma unroll
                for (int k = 0; k < 8; ++k) { x[k] -= mean; s2 += x[k] * x[k]; }
                const float rstd = 1.f / sqrtf(wave_sum(s2) * (1.f / AW) + LN_EPS);
                const int c0 = 8 * F.lane;
#pragma unroll
                for (int k = 0; k < 8; ++k) { const float v = x[k] * rstd * a_g[c0 + k] + a_b[c0 + k]; Vn[t * 512 + c0 + k] = v; F.out[OUT_AV + (size_t)(n * 4 + t) * AW + c0 + k] = v; }
            }
            __syncthreads();
            {
                const int c = F.tid, g = c >> 7;
                float ext[6]; ext[0] = INP(2)[(size_t)(n * 2 + 0) * 512 + c]; ext[1] = INP(2)[(size_t)(n * 2 + 1) * 512 + c];
#pragma unroll
                for (int t = 0; t < 4; ++t) ext[2 + t] = H0[(size_t)(R0 + t) * ECOLS + E_C + c] * H0[(size_t)(R0 + t) * ECOLS + E_H + c];
                const float w0 = bcw[c], w1 = bcw[512 + c], w2 = bcw[1024 + c];
#pragma unroll
                for (int t = 0; t < 4; ++t) {
                    float mix = a_bs[g * 128 + t];
#pragma unroll
                    for (int s = 0; s <= t; ++s) mix += a_ws[(size_t)(g * 128 + t) * 128 + s] * Vn[s * 512 + c];
                    const float ao = gelu_t(H0[(size_t)(R0 + t) * ECOLS + E_U + c]) * mix;
                    const float cv = w2 * ext[t + 2] + w1 * ext[t + 1] + w0 * ext[t];
                    const float bo = H0[(size_t)(R0 + t) * ECOLS + E_B + c] * cv;
                    AO[(size_t)(R0 + t) * D + c] = (bf16)f2bf(ao); AO[(size_t)(R0 + t) * D + 512 + c] = (bf16)f2bf(bo);
                }
                F.out[OUT_BS + (size_t)(n * 2 + 0) * 512 + c] = ext[4]; F.out[OUT_BS + (size_t)(n * 2 + 1) * 512 + c] = ext[5];
            }
            __syncthreads();
        }
    }
}

__device__ __forceinline__ void conv_gate_phase(Frame& F, int layer) {
    const float* HU = (const float*)(F.ws + WS_HU); bf16* G = (bf16*)(F.ws + WS_G);
    const float* cw = INP(23) + (size_t)layer * 3 * DFF2; const float* cb = INP(24) + (size_t)layer * DFF2;
    const float* st = INP(7) + (size_t)layer * NSQ * 2 * DFF2;
    const int NV = DFF / 4;
    const long total = (long)M * NV;
    for (long it = (long)F.vcu * NTHR + F.tid; it < total; it += (long)F.G * NTHR) {
        const int r = (int)(it / NV), j = (int)(it % NV) * 4;
        f32x4 ha[3], hb[3];
        const float* cur = HU + (size_t)r * DFF2;
        ha[2] = *(const f32x4*)(cur + j); hb[2] = *(const f32x4*)(cur + DFF + j);
        if (r < NP) {
            const int t = r & (SEQ - 1);
            if (t >= 1) { ha[1] = *(const f32x4*)(cur - DFF2 + j); hb[1] = *(const f32x4*)(cur - DFF2 + DFF + j); } else { ha[1] = (f32x4){0.f, 0.f, 0.f, 0.f}; hb[1] = ha[1]; }
            if (t >= 2) { ha[0] = *(const f32x4*)(cur - 2 * DFF2 + j); hb[0] = *(const f32x4*)(cur - 2 * DFF2 + DFF + j); } else { ha[0] = (f32x4){0.f, 0.f, 0.f, 0.f}; hb[0] = ha[0]; }
        } else {
            const int n = (r - NP) >> 2, t = (r - NP) & 3;
            const float* s0 = st + (size_t)(n * 2 + 0) * DFF2; const float* s1 = st + (size_t)(n * 2 + 1) * DFF2;
            const float* e1 = (t >= 1) ? cur - DFF2 : s1;
            const float* e0 = (t >= 2) ? cur - 2 * DFF2 : (t == 1 ? s1 : s0);
            ha[1] = *(const f32x4*)(e1 + j); hb[1] = *(const f32x4*)(e1 + DFF + j);
            ha[0] = *(const f32x4*)(e0 + j); hb[0] = *(const f32x4*)(e0 + DFF + j);
        }
        f32x4 xa = *(const f32x4*)(cb + j), xb = *(const f32x4*)(cb + DFF + j);
#pragma unroll
        for (int k = 0; k < 3; ++k) { xa += ha[k] * *(const f32x4*)(cw + (size_t)k * DFF2 + j); xb += hb[k] * *(const f32x4*)(cw + (size_t)k * DFF2 + DFF + j); }
        const float g0 = silu_f(xa.x) * xb.x, g1 = silu_f(xa.y) * xb.y, g2 = silu_f(xa.z) * xb.z, g3 = silu_f(xa.w) * xb.w;
        *(v2u*)(G + (size_t)r * DFF + j) = (v2u){pk2(g0, g1), pk2(g2, g3)};
    }
    const int NV2 = DFF2 / 4;
    const long tot2 = (long)(NB + NSQ) * 2 * NV2;
    for (long it = (long)F.vcu * NTHR + F.tid; it < tot2; it += (long)F.G * NTHR) {
        const int j = (int)(it % NV2) * 4, q = (int)(it / NV2), k = q & 1, sq = q >> 1;
        if (sq < NB) *(f32x4*)(F.out + OUT_FP + ((size_t)(layer * NB + sq) * 2 + k) * DFF2 + j) = *(const f32x4*)(HU + (size_t)(sq * SEQ + SEQ - 2 + k) * DFF2 + j);
        else { const int n = sq - NB; *(f32x4*)(F.out + OUT_FS + ((size_t)(layer * NSQ + n) * 2 + k) * DFF2 + j) = *(const f32x4*)(HU + (size_t)(NP + 4 * n + 2 + k) * DFF2 + j); }
    }
}
__device__ __forceinline__ void p10_post_odd(Frame& F) {
    const float* H1 = (const float*)(F.ws + WS_H);
    float* QR = (float*)(F.ws + WS_QR); float* KR = (float*)(F.ws + WS_KR); float* QI = (float*)(F.ws + WS_QI); float* KI = (float*)(F.ws + WS_KI);
    bf16* AO = (bf16*)(F.ws + WS_AO);
    bf16* QB = (bf16*)(F.ws + WS_QB); bf16* KB = (bf16*)(F.ws + WS_KB); bf16* VB = (bf16*)(F.ws + WS_VB); bf16* QIB = (bf16*)(F.ws + WS_QIB); bf16* KIB = (bf16*)(F.ws + WS_KIB);
    const float QSC = 0.125f * 1.4426950408889634f;
    const float* ct = (const float*)(F.ws + WS_ROPE); const float* st = ct + 4096 * 8;
    const float* cwt = INP(17); const float* csc = INP(18); const float* spool = INP(3);
    LAS float* pl = (LAS float*)(F.lds + F.wave * 4096);
    const int gw = F.vcu * NWAVES + F.wave, NGW = F.G * NWAVES, lane = F.lane;
    for (int r = gw; r < M; r += NGW) {
        const bool smp = r >= NP; const int n = (r - NP) >> 2, tsm = (r - NP) & 3, b = r >> 12, t = r & (SEQ - 1);
        const int pos = smp ? PAST + tsm : t;
        const float* h = H1 + (size_t)r * OCOLS_P;
        const int sub = lane & 7;
        f32x4 cA = {1.f, 1.f, 1.f, 1.f}, cB = cA, sA = {0.f, 0.f, 0.f, 0.f}, sB = sA;
        if (sub < 2) { cA = *(const f32x4*)(ct + pos * 8); cB = *(const f32x4*)(ct + pos * 8 + 4); sA = *(const f32x4*)(st + pos * 8); sB = *(const f32x4*)(st + pos * 8 + 4);
            if (sub == 0) { sA = -sA; sB = -sB; } }
#pragma unroll
        for (int which = 0; which < 3; ++which) {
            const int cbase = which == 0 ? O_Q : (which == 1 ? O_K : O_QI);
            f32x4 a = *(const f32x4*)(h + cbase + 8 * lane), c = *(const f32x4*)(h + cbase + 8 * lane + 4);
            f32x4 oa, oc;
            oa.x = __shfl_xor(a.x, 1); oa.y = __shfl_xor(a.y, 1); oa.z = __shfl_xor(a.z, 1); oa.w = __shfl_xor(a.w, 1);
            oc.x = __shfl_xor(c.x, 1); oc.y = __shfl_xor(c.y, 1); oc.z = __shfl_xor(c.z, 1); oc.w = __shfl_xor(c.w, 1);
            if (sub < 2) { a = a * cA + oa * sA; c = c * cB + oc * sB; }
            float* dst = (which == 0 ? QR : (which == 1 ? KR : QI)) + (size_t)r * 512 + 8 * lane;
            *(f32x4*)dst = a; *(f32x4*)(dst + 4) = c;
            { bf16* db = (which == 0 ? QB : (which == 1 ? KB : QIB)) + (size_t)r * 512 + 8 * lane; const float s_ = (which == 0) ? QSC : 1.f;
              *(v4u*)db = (v4u){pk2(a.x * s_, a.y * s_), pk2(a.z * s_, a.w * s_), pk2(c.x * s_, c.y * s_), pk2(c.z * s_, c.w * s_)}; }
            if (which == 1) { float* o = smp ? F.out + OUT_KS + (size_t)(r - NP) * 512 + 8 * lane : F.out + OUT_KP + (size_t)r * 512 + 8 * lane; *(f32x4*)o = a; *(f32x4*)(o + 4) = c; }
        }
        { const f32x4 a = *(const f32x4*)(h + O_V + 8 * lane), c = *(const f32x4*)(h + O_V + 8 * lane + 4);
          float* o = smp ? F.out + OUT_VS + (size_t)(r - NP) * 512 + 8 * lane : F.out + OUT_VP + (size_t)r * 512 + 8 * lane; *(f32x4*)o = a; *(f32x4*)(o + 4) = c;
          *(v4u*)(VB + (size_t)r * 512 + 8 * lane) = (v4u){pk2(a.x, a.y), pk2(a.z, a.w), pk2(c.x, c.y), pk2(c.z, c.w)}; }
        { float v = h[O_KI + lane]; const float o = __shfl_xor(v, 8);
          if (lane < 16) { const float cc = ct[pos * 8 + (lane & 7)], ss = st[pos * 8 + (lane & 7)]; v = (lane < 8) ? v * cc - o * ss : v * cc + o * ss; }
          KI[(size_t)r * 64 + lane] = v; KIB[(size_t)r * 64 + lane] = (bf16)f2bf(v);
          if (smp) F.out[OUT_KIS + (size_t)(r - NP) * 64 + lane] = v; else F.out[OUT_KIP + (size_t)r * 64 + lane] = v; }
        {
            const int g = lane >> 4, w = 2 << g;
            const f32x4 xa = *(const f32x4*)(h + O_P + 8 * lane), xc = *(const f32x4*)(h + O_P + 8 * lane + 4);
            f32x4 sa = xa, sc = xc; float cnt;
            if (!smp) {
                const int lim = (t + 1 < w) ? t + 1 : w; cnt = (float)lim;
                for (int j = 1; j < lim; ++j) { const float* hj = h - (size_t)j * OCOLS_P + O_P + 8 * lane; sa += *(const f32x4*)hj; sc += *(const f32x4*)(hj + 4); }
            } else {
                cnt = (float)w;
                for (int j = 1; j < w; ++j) { const int e = 15 + tsm - j;
                    const float* hj = (e >= 15) ? H1 + (size_t)(NP + 4 * n + (e - 15)) * OCOLS_P + O_P + 8 * lane : spool + (size_t)(n * 15 + e) * 512 + 8 * lane;
                    sa += *(const f32x4*)hj; sc += *(const f32x4*)(hj + 4); }
            }
            const float ic = 1.f / cnt;
            const f32x4 pa = sa * ic - xa, pc = sc * ic - xc;
            *(LAS f32x4*)(pl + 8 * lane) = pa; *(LAS f32x4*)(pl + 8 * lane + 4) = pc;
            if (!smp) { if (t >= SEQ - 15) { float* o = F.out + OUT_CP + (size_t)(b * 15 + (t - (SEQ - 15))) * 512 + 8 * lane; *(f32x4*)o = xa; *(f32x4*)(o + 4) = xc; } }
            else { float* o = F.out + OUT_CS + (size_t)(n * 15 + 11 + tsm) * 512 + 8 * lane; *(f32x4*)o = xa; *(f32x4*)(o + 4) = xc;
                if (tsm == 0) for (int i = 0; i < 11; ++i) { const float* s = spool + (size_t)(n * 15 + 4 + i) * 512 + 8 * lane; float* o2 = F.out + OUT_CS + (size_t)(n * 15 + i) * 512 + 8 * lane;
                    *(f32x4*)o2 = *(const f32x4*)s; *(f32x4*)(o2 + 4) = *(const f32x4*)(s + 4); } }
            LDS_WAIT(); asm volatile("" ::: "memory");
            const int d0 = 8 * (lane & 15);
            f32x4 a0 = {0.f, 0.f, 0.f, 0.f}, a1 = a0;
            const float* wg = cwt + (size_t)g * 128 * 128 + d0;
#pragma unroll 4
            for (int c = 0; c < 128; ++c) { const float p = pl[g * 128 + c]; a0 += *(const f32x4*)(wg + (size_t)c * 128) * p; a1 += *(const f32x4*)(wg + (size_t)c * 128 + 4) * p; }
            a0 = a0 * *(const f32x4*)(csc + g * 128 + d0); a1 = a1 * *(const f32x4*)(csc + g * 128 + d0 + 4);
            *(v4u*)(AO + (size_t)r * D + g * 128 + d0) = (v4u){pk2(a0.x, a0.y), pk2(a0.z, a0.w), pk2(a1.x, a1.y), pk2(a1.z, a1.w)};
            LDS_WAIT(); asm volatile("" ::: "memory");
        }
    }
}
__device__ __forceinline__ unsigned sortable(float f) { const unsigned u = __builtin_bit_cast(unsigned, f); return (u & 0x80000000u) ? ~u : (u | 0x80000000u); }
template <int NJ>
__device__ __forceinline__ void topk_threshold(const unsigned (&key)[NJ], unsigned& T, int& need) {
    T = 0u;
#pragma unroll 1
    for (int bit = 31; bit >= 0; --bit) {
        const unsigned cand = T | (1u << bit); int cnt = 0;
#pragma unroll
        for (int j = 0; j < NJ; ++j) cnt += __builtin_popcountll(__ballot(key[j] >= cand));
        if (cnt >= TOPK) T = cand;
    }
    int cgt = 0;
#pragma unroll
    for (int j = 0; j < NJ; ++j) cgt += __builtin_popcountll(__ballot(key[j] > T));
    need = TOPK - cgt;
}
template <int NJ>
__device__ __forceinline__ int select_topk(const unsigned (&key)[NJ], int N, int lane, int* sel) {
    const unsigned long long lt = (1ull << lane) - 1ull;
    if (N <= TOPK) { for (int s = lane; s < N; s += 64) sel[s] = s; return N; }
    unsigned T; int need; topk_threshold<NJ>(key, T, need);
    int outpos = 0, tseen = 0;
#pragma unroll
    for (int j = 0; j < NJ; ++j) {
        const bool gt = key[j] > T, eq = key[j] == T;
        const unsigned long long beq = __ballot(eq);
        const int tr = tseen + __builtin_popcountll(beq & lt);
        const bool s_ = gt || (eq && tr < need);
        const unsigned long long bs = __ballot(s_);
        if (s_) sel[outpos + __builtin_popcountll(bs & lt)] = 64 * j + lane;
        outpos += __builtin_popcountll(bs); tseen += __builtin_popcountll(beq);
    }
    return outpos;
}
template <int NJ>
__device__ __forceinline__ unsigned long long select_mask(const LAS float* srow, int N, int lane) {
    unsigned key[NJ];
#pragma unroll
    for (int j = 0; j < NJ; ++j) { const int s = 64 * j + lane; key[j] = (s < N) ? sortable(srow[s]) : 0u; }
    const unsigned long long lt = (1ull << lane) - 1ull;
    unsigned T; int need; topk_threshold<NJ>(key, T, need);
    unsigned long long mine = 0ull; int tseen = 0;
#pragma unroll
    for (int j = 0; j < NJ; ++j) {
        const bool gt = key[j] > T, eq = key[j] == T;
        const unsigned long long beq = __ballot(eq);
        const int tr = tseen + __builtin_popcountll(beq & lt);
        const unsigned long long bs = __ballot(gt || (eq && tr < need));
        if (lane == j) mine = bs;
        tseen += __builtin_popcountll(beq);
    }
    return mine;
}
constexpr int SPITCH = 4112;
typedef short bf16x8v __attribute__((ext_vector_type(8)));
__device__ __forceinline__ void p11_indexer(Frame& F) {
    const bf16* QIb = (const bf16*)(F.ws + WS_QIB); const bf16* KIb = (const bf16*)(F.ws + WS_KIB); const float* H1 = (const float*)(F.ws + WS_H);
    unsigned long long* MASK = (unsigned long long*)(F.ws + WS_MASK);
    LAS float* S = (LAS float*)F.lds;
    const int lane = F.lane, col = lane & 15, kq = lane >> 4, q = col & 7, hh = col >> 3;
    for (int u = F.vcu; u < 2048; u += F.G) {
        const int w = u & 255, i = u >> 8, b = w & 3, j = w >> 2;
        const int qb = (i >> 1) * 128 + ((i & 1) ? 127 - j : j);
        const int R0 = b * SEQ + 8 * qb, nkt = (8 * qb + 8 + 15) >> 4;
        bf16x8v Bf[4][2]; float wv[4];
#pragma unroll
        for (int p = 0; p < 4; ++p) {
#pragma unroll
            for (int ks = 0; ks < 2; ++ks) Bf[p][ks] = *(const bf16x8v*)(QIb + (size_t)(R0 + q) * 512 + (2 * p + hh) * 64 + 32 * ks + 8 * kq);
            wv[p] = H1[(size_t)(R0 + q) * OCOLS_P + O_WI + 2 * p + hh];
        }
        for (int kt = F.wave; kt < nkt; kt += NWAVES) {
            const bf16* kp = KIb + (size_t)(b * SEQ + 16 * kt + col) * 64 + 8 * kq;
            const bf16x8v A0 = *(const bf16x8v*)kp, A1 = *(const bf16x8v*)(kp + 32);
            f32x4 sc = {0.f, 0.f, 0.f, 0.f};
#pragma unroll
            for (int p = 0; p < 4; ++p) {
                f32x4 d = __builtin_amdgcn_mfma_f32_16x16x32_bf16(A0, Bf[p][0], (f32x4){0.f, 0.f, 0.f, 0.f}, 0, 0, 0);
                d = __builtin_amdgcn_mfma_f32_16x16x32_bf16(A1, Bf[p][1], d, 0, 0, 0);
                sc.x += wv[p] * fmaxf(d.x, 0.f); sc.y += wv[p] * fmaxf(d.y, 0.f); sc.z += wv[p] * fmaxf(d.z, 0.f); sc.w += wv[p] * fmaxf(d.w, 0.f);
            }
            sc.x += __shfl_xor(sc.x, 8); sc.y += __shfl_xor(sc.y, 8); sc.z += __shfl_xor(sc.z, 8); sc.w += __shfl_xor(sc.w, 8);
            if (hh == 0) *(LAS f32x4*)(S + q * SPITCH + 16 * kt + 4 * kq) = sc;
        }
        __syncthreads();
        {
            const int qq = F.wave, t = 8 * qb + qq, N = t + 1, NJc = (N + 63) >> 6;
            const LAS float* srow = S + qq * SPITCH;
            unsigned long long mine;
            if (N <= TOPK) { const int full = N >> 6; mine = (lane < full) ? ~0ull : (lane == full ? ((1ull << (N & 63)) - 1ull) : 0ull); }
            else if (NJc <= 8) mine = select_mask<8>(srow, N, lane);
            else if (NJc <= 16) mine = select_mask<16>(srow, N, lane);
            else if (NJc <= 24) mine = select_mask<24>(srow, N, lane);
            else if (NJc <= 32) mine = select_mask<32>(srow, N, lane);
            else if (NJc <= 40) mine = select_mask<40>(srow, N, lane);
            else if (NJc <= 48) mine = select_mask<48>(srow, N, lane);
            else if (NJc <= 56) mine = select_mask<56>(srow, N, lane);
            else mine = select_mask<64>(srow, N, lane);
            MASK[(size_t)(R0 + qq) * 64 + lane] = mine;
        }
        __syncthreads();
    }
    const float* QI = (const float*)(F.ws + WS_QI); const float* KI = (const float*)(F.ws + WS_KI);
    int* SEL = (int*)(F.ws + WS_SEL); int* NSEL = (int*)(F.ws + WS_NSEL);
    float* SC = (float*)(F.ws + WS_SC) + (size_t)blockIdx.x * 4 * 4096;
    const int* ptab = (const int*)INP(8); const float* ckidx = INP(6);
    LAS float* q_l = (LAS float*)F.lds;
    LAS float* w_l = (LAS float*)(F.lds + 8192);
    for (int n = F.vcu; n < NSQ; n += F.G) {
        const int R0 = NP + 4 * n, nk = PAST + 4;
        for (int e = F.tid; e < 4 * 512 / 4; e += NTHR) *(LAS f32x4*)(q_l + 4 * e) = *(const f32x4*)(QI + (size_t)R0 * 512 + 4 * e);
        if (F.tid < 32) w_l[F.tid] = H1[(size_t)(R0 + (F.tid >> 3)) * OCOLS_P + O_WI + (F.tid & 7)];
        __syncthreads();
        for (int s = F.tid; s < nk; s += NTHR) {
            const float* kp = (s < PAST) ? ckidx + ((size_t)ptab[n * NPAGES + (s >> 7)] * PAGE + (s & 127)) * 64 : KI + (size_t)(NP + 4 * n + (s - PAST)) * 64;
            f32x4 kv[16];
#pragma unroll
            for (int d = 0; d < 16; ++d) kv[d] = *(const f32x4*)(kp + 4 * d);
            for (int qi = 0; qi < 4; ++qi) {
                float sc = 0.f;
#pragma unroll
                for (int h = 0; h < 8; ++h) {
                    f32x4 a = {0.f, 0.f, 0.f, 0.f};
#pragma unroll
                    for (int d = 0; d < 16; ++d) a += *(const LAS f32x4*)(q_l + qi * 512 + h * 64 + 4 * d) * kv[d];
                    sc += w_l[qi * 8 + h] * fmaxf((a.x + a.y) + (a.z + a.w), 0.f);
                }
                SC[(size_t)qi * 4096 + s] = sc;
            }
        }
        __syncthreads();
        if (F.wave < 4) {
            const int qi = F.wave, N = PAST + qi + 1;
            unsigned key[33];
#pragma unroll
            for (int jj = 0; jj < 33; ++jj) { const int s = 64 * jj + lane; key[jj] = (s < N) ? sortable(SC[(size_t)qi * 4096 + s]) : 0u; }
            const int cnt = select_topk<33>(key, N, lane, SEL + (size_t)(R0 + qi) * TOPK);
            if (lane == 0) NSEL[R0 + qi] = cnt;
        }
        __syncthreads();
    }
}

__device__ __forceinline__ void p12_attention_sample(Frame& F, LAS unsigned char* lds) {
    const float* QR = (const float*)(F.ws + WS_QR); const float* KR = (const float*)(F.ws + WS_KR); const float* H1 = (const float*)(F.ws + WS_H);
    const int* SEL = (const int*)(F.ws + WS_SEL); const int* NSEL = (const int*)(F.ws + WS_NSEL);
    const int* ptab = (const int*)INP(8); const float* ck = INP(4); const float* cv = INP(5);
    bf16* AO = (bf16*)(F.ws + WS_AO);
    LAS float* cmb = (LAS float*)lds;
    const int lane = F.lane;
    for (int pr = F.vcu; pr < NSR / 2; pr += F.G) {
        const int r = NP + 2 * pr + (F.wave >> 2), part = F.wave & 3, n = (r - NP) >> 2;
        const f32x4 qa = *(const f32x4*)(QR + (size_t)r * 512 + 8 * lane) * ATT_SCALE, qc = *(const f32x4*)(QR + (size_t)r * 512 + 8 * lane + 4) * ATT_SCALE;
        const int cnt = NSEL[r]; const int* sel = SEL + (size_t)r * TOPK;
        float mx = -INFINITY, ls = 0.f; f32x4 oa = {0.f, 0.f, 0.f, 0.f}, oc = oa;
        for (int i0 = part * 64; i0 < part * 64 + 64; i0 += 4) {
            f32x4 ka[4], kc[4], va[4], vc[4];
#pragma unroll
            for (int e = 0; e < 4; ++e) {
                const int i = i0 + e; const int s = (i < cnt) ? sel[i] : 0;
                const float* kp; const float* vp;
                if (s < PAST) { const size_t ro = ((size_t)ptab[n * NPAGES + (s >> 7)] * PAGE + (s & 127)) * 512; kp = ck + ro; vp = cv + ro; }
                else { const int rr = NP + 4 * n + (s - PAST); kp = KR + (size_t)rr * 512; vp = H1 + (size_t)rr * OCOLS_P + O_V; }
                ka[e] = *(const f32x4*)(kp + 8 * lane); kc[e] = *(const f32x4*)(kp + 8 * lane + 4); va[e] = *(const f32x4*)(vp + 8 * lane); vc[e] = *(const f32x4*)(vp + 8 * lane + 4);
            }
#pragma unroll
            for (int e = 0; e < 4; ++e) {
                const f32x4 pr4 = qa * ka[e] + qc * kc[e];
                float lg = (pr4.x + pr4.y) + (pr4.z + pr4.w);
                lg += __shfl_xor(lg, 1); lg += __shfl_xor(lg, 2); lg += __shfl_xor(lg, 4);
                if (i0 + e >= cnt) lg = -INFINITY;
                const float mn = fmaxf(mx, lg);
                if (mn > -INFINITY) { const float sc = __expf(mx - mn), p = __expf(lg - mn); ls = ls * sc + p; oa = oa * sc + va[e] * p; oc = oc * sc + vc[e] * p; mx = mn; }
            }
        }
        LAS float* my = cmb + (F.wave * 64 + lane) * 10;
        my[0] = mx; my[1] = ls; my[2] = oa.x; my[3] = oa.y; my[4] = oa.z; my[5] = oa.w; my[6] = oc.x; my[7] = oc.y; my[8] = oc.z; my[9] = oc.w;
        __syncthreads();
        if (part == 0) {
            float M = -INFINITY;
#pragma unroll
            for (int k = 0; k < 4; ++k) M = fmaxf(M, cmb[((F.wave + k) * 64 + lane) * 10]);
            float L = 0.f, o[8] = {0.f, 0.f, 0.f, 0.f, 0.f, 0.f, 0.f, 0.f};
#pragma unroll
            for (int k = 0; k < 4; ++k) { const LAS float* pk = cmb + ((F.wave + k) * 64 + lane) * 10; const float m = pk[0];
                if (m > -INFINITY) { const float f = __expf(m - M); L += pk[1] * f;
#pragma unroll
                    for (int d = 0; d < 8; ++d) o[d] += pk[2 + d] * f; } }
            const float il = 1.f / L;
            *(v4u*)(AO + (size_t)r * D + 512 + 8 * lane) = (v4u){pk2(o[0] * il, o[1] * il), pk2(o[2] * il, o[3] * il), pk2(o[4] * il, o[5] * il), pk2(o[6] * il, o[7] * il)};
        }
        __syncthreads();
    }
}
constexpr int N_PHASES = 19;
struct Args { const float* in[28]; float* out; unsigned char* ws; int ph_lo, ph_hi; };
__global__ void __launch_bounds__(NTHR, 2) fwd(Args args) {
    extern __shared__ __attribute__((aligned(16))) unsigned char lds[];
    Frame F;
    F.lds = (LAS unsigned char*)lds;
    F.MISC = (volatile LAS unsigned*)(F.lds + MISC_OFF);
    F.tid = threadIdx.x; F.lane = F.tid & 63; F.wave = __builtin_amdgcn_readfirstlane(F.tid >> 6);
    F.G = gridDim.x; { const int bx = blockIdx.x; F.vcu = (F.G % 8 == 0) ? (bx % 8) * (F.G / 8) + bx / 8 : bx; }
    F.out = args.out; F.ws = args.ws;
    F.ctl = (gu32*)(F.ws + WS_CTL);
    for (int u = F.tid; u < (LDS_BYTES - LDSCTL_OFF) / 4; u += NTHR) ((LAS unsigned*)(F.lds + LDSCTL_OFF))[u] = 0u;
    F.itab = (const LAS unsigned long long*)(F.lds + ITAB_OFF);
    if (F.tid < 28) ((LAS unsigned long long*)(F.lds + ITAB_OFF))[F.tid] = (unsigned long long)args.in[F.tid];
    __syncthreads();
    XcdBarrier bar = xcd_barrier_post((unsigned*)(F.ctl + CW_BAR), F.MISC + 8);
    const int lo = args.ph_lo, hi = args.ph_hi;
#define IN(k) (lo <= (k) && (k) < hi)
#define SEAM(k) do { if (IN(k) && IN((k) + 1)) xcd_barrier(bar); asm volatile("" : "+v"(F.tid), "+v"(F.lane)); } while (0)
#define GEMM_F32(Aoff, Boff, Nn, Kk, Coff) do { pg8::Gemm g{(const pg8::bf16_t*)(F.ws + (Aoff)), (const pg8::bf16_t*)(F.ws + (Boff)), M, (Nn), (Kk)}; pg8::StaticOrder S; S.init(M, (Nn), F.G, (int)blockIdx.x); \
        pg8::EpiF32 E{(float*)(F.ws + (Coff)), (Nn)}; pg8::gemm_phase<pg8::EpiF32, pg8::StaticOrder, true, true>(F.lds, g, S, E); } while (0)

    if (IN(0)) { p0_prologue(F); } SEAM(0);
    if (IN(1)) { GEMM_F32(WS_XB0, WS_WINE, ECOLS, D, WS_H); } SEAM(1);
    if (IN(2)) { p2_mixer_even(F); } SEAM(2);
    if (IN(3)) { GEMM_F32(WS_AO, WS_WOUTE, D, D, WS_Y); } SEAM(3);
    if (IN(4)) { ln_phase(F, INP(0), INP(1), (const float*)(F.ws + WS_Y), INP(20), INP(21), (float*)(F.ws + WS_XF0), (bf16*)(F.ws + WS_XBF0)); } SEAM(4);
    if (IN(5)) { GEMM_F32(WS_XBF0, WS_WUP, DFF2, D, WS_HU); } SEAM(5);
    if (IN(6)) { conv_gate_phase(F, 0); } SEAM(6);
    if (IN(7)) { GEMM_F32(WS_G, WS_WDN, D, DFF, WS_Y); } SEAM(7);
    if (IN(8)) { const float* x1 = (const float*)(F.ws + WS_XF0); ln_phase(F, x1, x1 + (size_t)NP * D, (const float*)(F.ws + WS_Y), INP(26), INP(27), (float*)(F.ws + WS_XF1), (bf16*)(F.ws + WS_XBF1)); } SEAM(8);
    if (IN(9)) { GEMM_F32(WS_XBF1, WS_WINO, OCOLS_P, D, WS_H); } SEAM(9);
    if (IN(10)) { p10_post_odd(F); } SEAM(10);
    if (IN(11)) { p11_indexer(F); } SEAM(11);
    if (IN(12)) {
        const attn_body::AttnTensors AT{(const attn_body::bf16*)(F.ws + WS_QB), (const attn_body::bf16*)(F.ws + WS_KB), (const attn_body::bf16*)(F.ws + WS_VB), (attn_body::bf16*)(F.ws + WS_AO) + 512, (const unsigned long long*)(F.ws + WS_MASK)};
        const attn_body::StaticOrder AS((int)F.G, F.vcu);
        attn_body::attn_phase<attn_body::StaticOrder>((char*)lds, AT, AS);
        p12_attention_sample(F, F.lds + 98304);
    } SEAM(12);
    if (IN(13)) { GEMM_F32(WS_AO, WS_WOUTO, D, D, WS_Y); } SEAM(13);
    if (IN(14)) { const float* x2 = (const float*)(F.ws + WS_XF1); ln_phase(F, x2, x2 + (size_t)NP * D, (const float*)(F.ws + WS_Y), INP(20) + D, INP(21) + D, (float*)(F.ws + WS_XF0), (bf16*)(F.ws + WS_XBF0)); } SEAM(14);
    if (IN(15)) { GEMM_F32(WS_XBF0, WS_WUP + WUP_BYTES, DFF2, D, WS_HU); } SEAM(15);
    if (IN(16)) { conv_gate_phase(F, 1); } SEAM(16);
    if (IN(17)) { GEMM_F32(WS_G, WS_WDN + WDN_BYTES, D, DFF, WS_Y); } SEAM(17);
    if (IN(18)) { const float* x3 = (const float*)(F.ws + WS_XF0); ln_phase(F, x3, x3 + (size_t)NP * D, (const float*)(F.ws + WS_Y), INP(26) + D, INP(27) + D, F.out + OUT_YP, (bf16*)nullptr); }
#undef IN
#undef SEAM
}

#ifndef MK_N_LAUNCHES
#define MK_N_LAUNCHES 1
#endif
extern "C" void kernel_launch(void* const* d_in, const int* in_sizes, int n_in, void* d_out, int out_size, void* d_ws, size_t ws_size, hipStream_t stream) {
    static int grid = 0;
    if (grid == 0) {
        if (n_in != 28 || out_size != (int)OUT_END || ws_size < WS_END) { fprintf(stderr, "kernel_launch: unexpected sizes: n_in %d out %d ws %zu\n", n_in, out_size, ws_size); grid = -1; return; }
        int dev = 0, cus = 0, per_cu = 0;
        if (hipGetDevice(&dev) != hipSuccess || hipDeviceGetAttribute(&cus, hipDeviceAttributeMultiprocessorCount, dev) != hipSuccess) { grid = -1; return; }
        if (hipFuncSetAttribute((const void*)fwd, hipFuncAttributeMaxDynamicSharedMemorySize, LDS_BYTES) != hipSuccess) { fprintf(stderr, "kernel_launch: hipFuncSetAttribute failed\n"); grid = -1; return; }
        if (hipOccupancyMaxActiveBlocksPerMultiprocessor(&per_cu, (const void*)fwd, NTHR, LDS_BYTES) != hipSuccess || per_cu < 1) fprintf(stderr, "kernel_launch: occupancy query reports %d\n", per_cu);
        (void)hipGetLastError();
        grid = cus;
    }
    if (grid < 0) return;
    if (hipMemsetAsync((char*)d_ws + WS_CTL, 0, CTL_ZERO_BYTES, stream) != hipSuccess) return;
    Args a{};
    for (int i = 0; i < 28; ++i) a.in[i] = (const float*)d_in[i];
    a.out = (float*)d_out; a.ws = (unsigned char*)d_ws;
#if MK_N_LAUNCHES == 1
    a.ph_lo = 0; a.ph_hi = N_PHASES;
    hipLaunchKernelGGL(fwd, dim3(grid), dim3(NTHR), LDS_BYTES, stream, a);
#else
    for (int p = 0; p < N_PHASES; ++p) { a.ph_lo = p; a.ph_hi = p + 1; hipLaunchKernelGGL(fwd, dim3(grid), dim3(NTHR), LDS_BYTES, stream, a); }
#endif
}
```

```cpp
#include <hip/hip_runtime.h>
#include <cstdio>
#include <cstdint>
__device__ __forceinline__ int hw_lane() { int l; asm volatile("v_mbcnt_lo_u32_b32 %0, -1, 0\n\tv_mbcnt_hi_u32_b32 %0, -1, %0" : "=v"(l)); return l; }
namespace pg8 {
#define PG8_LAS __attribute__((address_space(3)))
typedef unsigned short bf16_t;
typedef short bf16x8 __attribute__((ext_vector_type(8)));
typedef float f32x4 __attribute__((ext_vector_type(4)));
typedef unsigned u32x4 __attribute__((ext_vector_type(4)));
constexpr int BM = 256, BK = 64, HALF = 128, HTB = HALF * BK * 2  , STAGE_BYTES = 8 * HTB, NXCD = 8, WGM = 8;

__host__ __device__ __forceinline__ int lds_byte(int r, int c) { const int st = (r >> 4) * 2 + (c >> 5), rr = r & 15, cc = c & 31, ob = rr * 64 + cc * 2; return st * 1024 + (ob ^ (((ob >> 9) & 1) << 5)); }
__host__ __device__ __forceinline__ void stage_rc(int b, int& R, int& C) { const int st = b / 1024, sb = b % 1024, swz = sb ^ (((sb >> 9) & 1) << 5); R = (st >> 1) * 16 + swz / 64; C = (st & 1) * 32 + (swz % 64) / 2; }
__host__ __device__ __forceinline__ int perm32(int rho) { const int n = rho >> 4, i = rho & 15; return 8 * (i >> 2) + 4 * n + (i & 3); }

struct Unit { int pm, pn; };
struct Gemm { const bf16_t* A; const bf16_t* Bt; int M, N, K; };

struct StaticOrder {
    int nM, nN, nwg, G, c;
    __host__ __device__ void init(int M, int N, int G_, int c_) { nM = M / BM; nN = N / BM; nwg = nM * nN; G = G_; c = c_; }
    __host__ __device__ bool next(int i, Unit& u) const {
        const long L = (long)i * G + c; if (L >= nwg) return false;
        int wgid = (int)L; { const int q = nwg / NXCD, r = nwg % NXCD, xcd = wgid % NXCD, off = wgid / NXCD; wgid = (xcd < r ? xcd * (q + 1) : r * (q + 1) + (xcd - r) * q) + off; }
        const int nig = WGM * nN, gid = wgid / nig, fm = gid * WGM, gsz = (nM - fm) < WGM ? (nM - fm) : WGM;
        u.pm = fm + ((wgid % nig) % gsz); u.pn = (wgid % nig) / gsz; return true;
    }
    __device__ __forceinline__ void a_ready(const Unit&) const {}
    __device__ __forceinline__ void done(const Unit&) const {}
};

__device__ __forceinline__ unsigned cvt_pk_bf16(float lo, float hi) { unsigned r; asm volatile("v_cvt_pk_bf16_f32 %0, %1, %2" : "=v"(r) : "v"(lo), "v"(hi)); return r; }
struct EpiF32 {
    static constexpr bool PERM = true, AFTER_DRAIN = false;
    float* C; int ldc;
    __device__ __forceinline__ void operator()(const f32x4 (&acc)[2][2][4][2], const Unit& u, int wr, int wc, int fr, int fq) const {
        const int row0 = u.pm * BM + wr * 64 + fr, col0 = u.pn * BM + wc * 32 + 8 * fq;
#pragma unroll
        for (int ai = 0; ai < 2; ++ai)
#pragma unroll
            for (int m = 0; m < 4; ++m) { float* rowp = C + (size_t)(row0 + ai * HALF + m * 16) * ldc + col0;
#pragma unroll
                for (int bj = 0; bj < 2; ++bj) { *(f32x4*)(rowp + bj * HALF) = acc[ai][bj][m][0]; *(f32x4*)(rowp + bj * HALF + 4) = acc[ai][bj][m][1]; } }
    }
};
template <class Epi, class Sched, bool ALIGN_EPI = false, bool SP2 = false>
__device__ __forceinline__ void gemm_phase(PG8_LAS unsigned char* lds, const Gemm g, const Sched& S, const Epi& E, const int wid) {
    const int lane = hw_lane(), tid = wid * 64 + lane, wr = wid >> 2, wc = wid & 3, fr = lane & 15, fq = lane >> 4;
    const int K = g.K, nt = K / BK;
    unsigned voffA[2], voffB[2];
#pragma unroll
    for (int i = 0; i < 2; ++i) { int R, C; stage_rc(tid * 16 + i * 8192, R, C); const int Rb = Epi::PERM ? ((R & ~31) + perm32(R & 31)) : R;
        voffA[i] = (unsigned)(R * K + C) * 2u; voffB[i] = (unsigned)(Rb * K + C) * 2u; }
    const size_t kstep = (size_t)(BK * 2);
    const size_t hstep = (size_t)HALF * K * 2;
    const size_t tstep = 2 * hstep;
    const unsigned ldsw = (unsigned)wid * 1024u;
    const int aoff = lds_byte(wr * 64 + fr, fq * 8), boff = lds_byte(wc * 32 + fr, fq * 8);
#define PG8_SA(b, h) (((b) * 2 + (h)) * HTB)
#define PG8_SB(b, h) ((4 + (b) * 2 + (h)) * HTB)
#define PG8_STAGE(bufoff, gbase, voff) do { _Pragma("unroll") for (int _i = 0; _i < 2; ++_i) \
        __builtin_amdgcn_global_load_lds((const unsigned*)((const char*)(gbase) + (voff)[_i]), (PG8_LAS unsigned*)(lds + (bufoff) + ldsw + _i * 8192), 16, 0, 0); } while (0)
#define PG8_LDA(dst, b, h) do { _Pragma("unroll") for (int m = 0; m < 4; ++m) _Pragma("unroll") for (int k = 0; k < 2; ++k) dst[m][k] = *(const PG8_LAS bf16x8*)(lds + PG8_SA(b, h) + aoff + m * 2048 + k * 1024); } while (0)
#define PG8_LDB(dst, b, h) do { _Pragma("unroll") for (int n = 0; n < 2; ++n) _Pragma("unroll") for (int k = 0; k < 2; ++k) dst[n][k] = *(const PG8_LAS bf16x8*)(lds + PG8_SB(b, h) + boff + n * 2048 + k * 1024); } while (0)
#define PG8_MMA(ai, bj, At, Bt) do { __builtin_amdgcn_s_setprio(1); _Pragma("unroll") for (int m = 0; m < 4; ++m) _Pragma("unroll") for (int n = 0; n < 2; ++n) _Pragma("unroll") for (int k = 0; k < 2; ++k) \
        acc[ai][bj][m][n] = __builtin_amdgcn_mfma_f32_16x16x32_bf16(Bt[n][k], At[m][k], acc[ai][bj][m][n], 0, 0, 0); __builtin_amdgcn_s_setprio(0); } while (0)
#define PG8_WAIT_V(n) asm volatile("s_waitcnt vmcnt(" #n ")" ::: "memory")
#define PG8_WAIT_L(n) asm volatile("s_waitcnt lgkmcnt(" #n ")" ::: "memory")
#define PG8_BAR __builtin_amdgcn_s_barrier()
#define PG8_SCHED __builtin_amdgcn_sched_barrier(0)
    Unit cur, nxt; int ui = 0;
    if (!S.next(0, cur)) return;
    f32x4 acc[2][2][4][2];
#pragma unroll
    for (int a = 0; a < 2; ++a)
#pragma unroll
        for (int b = 0; b < 2; ++b)
#pragma unroll
            for (int m = 0; m < 4; ++m)
#pragma unroll
                for (int n = 0; n < 2; ++n) acc[a][b][m][n] = (f32x4){0.f, 0.f, 0.f, 0.f};
    bf16x8 At[4][2], B0[2][2], B1[2][2];
    const char* cA = (const char*)g.A + (size_t)cur.pm * tstep; const char* cB = (const char*)g.Bt + (size_t)cur.pn * tstep;
    S.a_ready(cur);
    if constexpr (SP2) {
        PG8_STAGE(PG8_SB(0, 0), cB, voffB); PG8_STAGE(PG8_SB(0, 1), cB + hstep, voffB); PG8_STAGE(PG8_SA(0, 0), cA, voffA); PG8_STAGE(PG8_SA(0, 1), cA + hstep, voffA);
        if (wr == 1) PG8_BAR;
        PG8_WAIT_V(2); PG8_BAR;
        PG8_STAGE(PG8_SB(1, 0), cB + kstep, voffB); PG8_STAGE(PG8_SA(1, 0), cA + kstep, voffA); PG8_STAGE(PG8_SB(1, 1), cB + hstep + kstep, voffB);
        PG8_WAIT_V(6); PG8_BAR;
    } else {
        PG8_STAGE(PG8_SB(0, 0), cB, voffB); PG8_STAGE(PG8_SA(0, 0), cA, voffA); PG8_STAGE(PG8_SB(0, 1), cB + hstep, voffB); PG8_STAGE(PG8_SA(0, 1), cA + hstep, voffA);
        if (wr == 1) PG8_BAR;
        PG8_WAIT_V(4); PG8_BAR;
        PG8_STAGE(PG8_SB(1, 0), cB + kstep, voffB); PG8_STAGE(PG8_SA(1, 0), cA + kstep, voffA); PG8_STAGE(PG8_SB(1, 1), cB + hstep + kstep, voffB);
        PG8_WAIT_V(6); PG8_BAR;
    }
    for (;;) {
        const bool has_next = S.next(ui + 1, nxt);
        const char* nA = has_next ? (const char*)g.A + (size_t)nxt.pm * tstep : cA; const char* nB = has_next ? (const char*)g.Bt + (size_t)nxt.pn * tstep : cB;
        for (int t = 0; t < nt; t += 2) {
            const bool last = (t == nt - 2);
            const char* a1 = cA + (size_t)(t + 1) * kstep;
            const char* a2 = last ? nA : cA + (size_t)(t + 2) * kstep; const char* b2 = last ? nB : cB + (size_t)(t + 2) * kstep;
            const char* a3 = a2 + kstep; const char* b3 = b2 + kstep;
            if (last && has_next) S.a_ready(nxt);
            if constexpr (SP2) {
            PG8_LDB(B0, 0, 0); PG8_LDB(B1, 0, 1); PG8_SCHED; PG8_LDA(At, 0, 0); PG8_STAGE(PG8_SA(1, 1), a1 + hstep, voffA);
            PG8_WAIT_V(8); PG8_WAIT_L(0); PG8_BAR; PG8_MMA(0, 0, At, B0); PG8_MMA(0, 1, At, B1); PG8_BAR; PG8_SCHED;
            PG8_LDA(At, 0, 1); PG8_STAGE(PG8_SB(0, 0), b2, voffB); PG8_STAGE(PG8_SB(0, 1), b2 + hstep, voffB); PG8_STAGE(PG8_SA(0, 0), a2, voffA);
            PG8_WAIT_V(8); PG8_WAIT_L(0); PG8_BAR; PG8_MMA(1, 0, At, B0); PG8_MMA(1, 1, At, B1); PG8_BAR; PG8_SCHED;
            PG8_LDB(B0, 1, 0); PG8_LDB(B1, 1, 1); PG8_SCHED; PG8_LDA(At, 1, 0); PG8_STAGE(PG8_SA(0, 1), a2 + hstep, voffA);
            PG8_WAIT_V(8); PG8_WAIT_L(0); PG8_BAR; PG8_MMA(0, 0, At, B0); PG8_MMA(0, 1, At, B1); PG8_BAR; PG8_SCHED;
            PG8_LDA(At, 1, 1); PG8_STAGE(PG8_SB(1, 0), b3, voffB); PG8_STAGE(PG8_SB(1, 1), b3 + hstep, voffB); PG8_STAGE(PG8_SA(1, 0), a3, voffA);
            PG8_WAIT_V(8); PG8_WAIT_L(0); PG8_BAR; PG8_MMA(1, 0, At, B0); PG8_MMA(1, 1, At, B1); PG8_BAR; PG8_SCHED;
            } else {
            PG8_LDB(B0, 0, 0); PG8_SCHED; PG8_LDA(At, 0, 0); PG8_STAGE(PG8_SA(1, 1), a1 + hstep, voffA);
            PG8_WAIT_L(8); PG8_BAR; PG8_WAIT_L(0); PG8_MMA(0, 0, At, B0); PG8_BAR; PG8_SCHED;
            PG8_LDB(B1, 0, 1); PG8_STAGE(PG8_SB(0, 0), b2, voffB);
            PG8_BAR; PG8_WAIT_L(0); PG8_MMA(0, 1, At, B1); PG8_BAR;
            PG8_LDA(At, 0, 1); PG8_STAGE(PG8_SA(0, 0), a2, voffA);
            PG8_BAR; PG8_WAIT_L(0); PG8_MMA(1, 0, At, B0); PG8_BAR; PG8_SCHED;
            PG8_STAGE(PG8_SB(0, 1), b2 + hstep, voffB);
            PG8_WAIT_V(6); PG8_BAR; PG8_MMA(1, 1, At, B1); PG8_BAR;
            PG8_LDB(B0, 1, 0); PG8_SCHED; PG8_LDA(At, 1, 0); PG8_STAGE(PG8_SA(0, 1), a2 + hstep, voffA);
            PG8_WAIT_L(8); PG8_BAR; PG8_WAIT_L(0); PG8_MMA(0, 0, At, B0); PG8_BAR; PG8_SCHED;
            PG8_LDB(B1, 1, 1); PG8_STAGE(PG8_SB(1, 0), b3, voffB);
            PG8_BAR; PG8_WAIT_L(0); PG8_MMA(0, 1, At, B1); PG8_BAR;
            PG8_LDA(At, 1, 1); PG8_STAGE(PG8_SA(1, 0), a3, voffA);
            PG8_BAR; PG8_WAIT_L(0); PG8_MMA(1, 0, At, B0); PG8_BAR; PG8_SCHED;
            PG8_STAGE(PG8_SB(1, 1), b3 + hstep, voffB);
            PG8_WAIT_V(6); PG8_BAR; PG8_MMA(1, 1, At, B1); PG8_BAR;
            }
        }
        if constexpr (ALIGN_EPI) { if (wr == 0) PG8_BAR; }
        if constexpr (!Epi::AFTER_DRAIN) { E(acc, cur, wr, wc, fr, fq); S.done(cur); }
        if (!has_next) break;
#pragma unroll
        for (int a = 0; a < 2; ++a)
#pragma unroll
            for (int b = 0; b < 2; ++b)
#pragma unroll
                for (int m = 0; m < 4; ++m)
#pragma unroll
                    for (int n = 0; n < 2; ++n) acc[a][b][m][n] = (f32x4){0.f, 0.f, 0.f, 0.f};
        cur = nxt; cA = nA; cB = nB; ++ui;
        if constexpr (ALIGN_EPI) { if (wr == 1) PG8_BAR; }
    }
    PG8_WAIT_V(0);
    if constexpr (!ALIGN_EPI) { if (wr == 0) PG8_BAR; }
    PG8_BAR;
    if constexpr (Epi::AFTER_DRAIN) { E.fused(acc, cur, wr, wc, fr, fq, lds, wid, lane); S.done(cur); }
#undef PG8_SA
#undef PG8_SB
#undef PG8_STAGE
#undef PG8_LDA
#undef PG8_LDB
#undef PG8_MMA
#undef PG8_WAIT_V
#undef PG8_WAIT_L
#undef PG8_BAR
#undef PG8_SCHED
}
}
#include <hip/hip_bf16.h>
#include <cmath>
namespace attn_body {
using bf16=__hip_bfloat16;
using bf16x8=__attribute__((ext_vector_type(8)))short;
using s16x4=__attribute__((ext_vector_type(4)))short;
using f32x16=__attribute__((ext_vector_type(16)))float;
using u32x4=__attribute__((ext_vector_type(4)))unsigned;
constexpr int BATCH=4,NHEAD=8,SEQ=4096,D=64,DM=NHEAD*D,OPITCH=1024;
constexpr int NW=8,QBLK=32,QB=QBLK*NW,KVBLK=64,NQB=SEQ/QB;
constexpr int ATTN_PITCH=DM, ATTN_UNIT_ROWS=QB;
__device__ __forceinline__ int crow(int r,int hi){return (r&3)+8*(r>>2)+4*hi;}
#define SBAR() __builtin_amdgcn_sched_barrier(0)
__device__ __forceinline__ void cmask(f32x16&p0,f32x16&p1,int jb,int qrel,int hi){
  const float NEG=-INFINITY; int kb=64*jb+4*hi;
  #pragma unroll
  for(int r=0;r<16;++r){int kv=kb+(r&3)+8*(r>>2); if(kv>qrel)p0[r]=NEG; if(kv+32>qrel)p1[r]=NEG;}
}

constexpr int NSLOT=3, SLOTB=8192;
constexpr int LDS_K=0, LDS_V=NSLOT*SLOTB, LDS_WS=2*NSLOT*SLOTB, LDS_OST=LDS_WS+NW*64*4, LDS_MSK=LDS_OST+NW*4096, LDS_BYTES=LDS_MSK+NW*1024;
constexpr float C2=0.125f*1.4426950408889634f;
__device__ __forceinline__ void glds16(const void*sbase,unsigned voff,unsigned lds_dst){unsigned keep;
  asm volatile("s_mov_b32 %0, m0\n\ts_mov_b32 m0, %3\n\ts_nop 0\n\tglobal_load_lds_dwordx4 %1, %2\n\ts_mov_b32 m0, %0":"=&s"(keep):"v"(voff),"s"(sbase),"s"(lds_dst):"memory");}
__device__ __forceinline__ float max3f(float a,float b,float c){float r;asm("v_max3_f32 %0, %1, %2, %3":"=v"(r):"v"(a),"v"(b),"v"(c));return r;}
__device__ __forceinline__ float max2f(float a,float b){float r;asm("v_max_f32_e32 %0, %1, %2":"=v"(r):"v"(a),"v"(b));return r;}
__device__ __forceinline__ float fadd_s(float a,float b){float r;asm("v_add_f32_e32 %0, %1, %2":"=v"(r):"v"(a),"v"(b));return r;}
__device__ __forceinline__ float fsub_s(float a,float b){float r;asm("v_sub_f32_e32 %0, %1, %2":"=v"(r):"v"(a),"v"(b));return r;}
typedef float f32x2_t __attribute__((ext_vector_type(2))); typedef __bf16 bf16x2_t __attribute__((ext_vector_type(2)));
__device__ __forceinline__ unsigned cvtpk_s(float lo,float hi){f32x2_t v={lo,hi};bf16x2_t b=__builtin_convertvector(v,bf16x2_t);return __builtin_bit_cast(unsigned,b);}
#define WAIT_BAR(N) asm volatile("s_waitcnt vmcnt(" #N ") lgkmcnt(0)\n\ts_barrier":::"memory")

__device__ __forceinline__ void qkt(f32x16&p0,f32x16&p1,const char*Kslot,const bf16x8*qr,const f32x16&negm,int r32,int hi){
  const char*kb=Kslot+hi*1024+r32*16;
  #pragma unroll
  for(int d0=0;d0<4;++d0){
    const bf16x8 b0=*reinterpret_cast<const bf16x8*>(kb+d0*2048);
    const bf16x8 b1=*reinterpret_cast<const bf16x8*>(kb+d0*2048+512);
    if(d0==0){p0=__builtin_amdgcn_mfma_f32_32x32x16_bf16(b0,qr[0],negm,0,0,0);p1=__builtin_amdgcn_mfma_f32_32x32x16_bf16(b1,qr[0],negm,0,0,0);}
    else{p0=__builtin_amdgcn_mfma_f32_32x32x16_bf16(b0,qr[d0],p0,0,0,0);p1=__builtin_amdgcn_mfma_f32_32x32x16_bf16(b1,qr[d0],p1,0,0,0);}}
}
typedef __attribute__((address_space(3))) const char* lds_cptr;
typedef short v4i16_t __attribute__((ext_vector_type(4)));
__device__ __forceinline__ void kload8(bf16x8*kf,lds_cptr kp){
  kf[0]=*(const __attribute__((address_space(3))) bf16x8*)(kp);      kf[1]=*(const __attribute__((address_space(3))) bf16x8*)(kp+512);
  kf[2]=*(const __attribute__((address_space(3))) bf16x8*)(kp+2048); kf[3]=*(const __attribute__((address_space(3))) bf16x8*)(kp+2560);
  kf[4]=*(const __attribute__((address_space(3))) bf16x8*)(kp+4096); kf[5]=*(const __attribute__((address_space(3))) bf16x8*)(kp+4608);
  kf[6]=*(const __attribute__((address_space(3))) bf16x8*)(kp+6144); kf[7]=*(const __attribute__((address_space(3))) bf16x8*)(kp+6656);
}
__device__ __forceinline__ void kload2(bf16x8*kf,lds_cptr kp,int j){ kf[2*j]=*(const __attribute__((address_space(3))) bf16x8*)(kp+j*2048); kf[2*j+1]=*(const __attribute__((address_space(3))) bf16x8*)(kp+j*2048+512); }
__device__ __forceinline__ s16x4 vtr(lds_cptr p){ return __builtin_bit_cast(s16x4,__builtin_amdgcn_ds_read_tr16_b64_v4i16((__attribute__((address_space(3))) v4i16_t*)p)); }
__device__ __forceinline__ float rowmax(const f32x16&p0,const f32x16&p1){
  float a=max3f(p0[0],p0[1],p1[0]),b=max3f(p0[2],p0[3],p1[1]);a=max3f(a,p1[2],p1[3]);
  #pragma unroll
  for(int r=4;r<16;r+=4){a=max3f(a,p0[r],p0[r+1]);b=max3f(b,p0[r+2],p0[r+3]);a=max3f(a,p1[r],p1[r+1]);b=max3f(b,p1[r+2],p1[r+3]);}
  const float m=max2f(a,b);
  auto rr=__builtin_amdgcn_permlane32_swap(__float_as_uint(m),__float_as_uint(m),false,false);
  return max2f(__uint_as_float(rr[0]),__uint_as_float(rr[1]));
}
__device__ __forceinline__ void pv(f32x16*o,int vb,bf16x8 pa0,bf16x8 pa1,bf16x8 pa2,bf16x8 pa3){
  #pragma unroll
  for(int d0=0;d0<2;++d0){s16x4 lo[4],hi[4];
    #pragma unroll
    for(int ks=0;ks<4;++ks){
      asm volatile("ds_read_b64_tr_b16 %0,%1 offset:%c2":"=&v"(lo[ks]):"v"(vb),"i"(d0*4096+ks*1024):"memory");
      asm volatile("ds_read_b64_tr_b16 %0,%1 offset:%c2":"=&v"(hi[ks]):"v"(vb),"i"(d0*4096+ks*1024+512):"memory");}
    asm volatile("s_waitcnt lgkmcnt(0)":::"memory");SBAR();
    #define PK(k) (bf16x8){lo[k][0],lo[k][1],lo[k][2],lo[k][3],hi[k][0],hi[k][1],hi[k][2],hi[k][3]}
    o[d0]=__builtin_amdgcn_mfma_f32_32x32x16_bf16(pa0,PK(0),o[d0],0,0,0);
    o[d0]=__builtin_amdgcn_mfma_f32_32x32x16_bf16(pa1,PK(1),o[d0],0,0,0);
    o[d0]=__builtin_amdgcn_mfma_f32_32x32x16_bf16(pa2,PK(2),o[d0],0,0,0);
    o[d0]=__builtin_amdgcn_mfma_f32_32x32x16_bf16(pa3,PK(3),o[d0],0,0,0);
    #undef PK
  }
}

#ifndef ATTN_STORE16
#define ATTN_STORE16(p,v) (*(u32x4*)(p)=(v))
#endif
__device__ __forceinline__ void glds4(const void*sbase,unsigned voff,unsigned lds_dst){unsigned keep;
  asm volatile("s_mov_b32 %0, m0\n\ts_mov_b32 m0, %3\n\ts_nop 0\n\tglobal_load_lds_dword %1, %2\n\ts_mov_b32 m0, %0":"=&s"(keep):"v"(voff),"s"(sbase),"s"(lds_dst):"memory");}
__device__ __forceinline__ float mand(float e,int w,int pos){return __uint_as_float(__float_as_uint(e)&(unsigned)__builtin_amdgcn_sbfe(w,pos,1));}
template<int THRL> __device__ __forceinline__ void attn_unit(int b,int h,int qb,const bf16*Q,const bf16*__restrict__ K,const bf16*__restrict__ V,bf16*O,const unsigned long long*MK,char*shm,const int wid){
  const int lane=hw_lane(),tid=wid*64+lane,r32=lane&31,hi=lane>>5;
  const long rowbase=(long)b*SEQ; const int q0=qb*QB;
  const bf16*Qw=Q+(rowbase+q0+wid*QBLK)*DM+h*D;
  const bf16*Kh=K+rowbase*DM+h*D,*Vh=V+rowbase*DM+h*D;
  typedef __attribute__((address_space(3))) const char* lds_cptr0; const lds_cptr0 shm3m=(lds_cptr0)shm;
  const unsigned lds0=(unsigned)(uintptr_t)shm;
  float*wsf=(float*)(shm+LDS_WS)+wid*64;
  const unsigned koff=(unsigned)(lane*DM+wid*8)*2u;
  const unsigned voff=(unsigned)((16*(wid&3)+(lane>>2))*DM+(wid>>2)*32+(lane&3)*8)*2u;
  const unsigned kdst=lds0+LDS_K+wid*1024, vdst=lds0+LDS_V+wid*1024;
  #define DMA_K(t,slot) glds16(Kh+(long)(t)*KVBLK*DM,koff,(unsigned)__builtin_amdgcn_readfirstlane(kdst+(slot)))
  #define DMA_V(t,slot) glds16(Vh+(long)(t)*KVBLK*DM,voff,(unsigned)__builtin_amdgcn_readfirstlane(vdst+(slot)))
  const int vb0=(int)(lds0+LDS_V)+((lane>>4)&1)*32+(lane&3)*8+(4*hi+((lane&15)>>2))*64;
  const char*Kbase=shm+LDS_K; bf16x8 kf[8];
  const lds_cptr shm3=(lds_cptr)shm; const lds_cptr kp0=shm3+LDS_K+hi*1024+r32*16; const lds_cptr vp0=shm3+LDS_V+((lane>>4)&1)*32+(lane&3)*8+(4*hi+((lane&15)>>2))*64;
  const int NT=(q0+QB)/KVBLK;
  const char*mrow=(const char*)(MK+(size_t)(rowbase+q0+wid*QBLK)*64); const unsigned moff=(unsigned)r32*512u;
  const unsigned mdst=lds0+LDS_MSK+wid*1024;
  typedef __attribute__((address_space(3))) const int* lds_iptr; const lds_iptr mp=(lds_iptr)(shm3m+LDS_MSK+wid*1024)+lane;
  #define MDMA(t,slot) do{ glds4(mrow+(long)(t)*8,moff,(unsigned)__builtin_amdgcn_readfirstlane(mdst+(slot)*512)); glds4(mrow+(long)(t)*8+4,moff,(unsigned)__builtin_amdgcn_readfirstlane(mdst+(slot)*512+256)); }while(0)
  #define MRD(slot,LO,HI) const int LO=mp[(slot)*128]>>(4*hi), HI=mp[(slot)*128+64]>>(4*hi)
  #define BP(r) (((r)&3)+8*((r)>>2))
  MDMA(0,0); MDMA(1,1);
  DMA_K(0,0);DMA_V(0,0);DMA_K(1,SLOTB);
  bf16x8 qr[4];
  #pragma unroll
  for(int d0=0;d0<4;++d0)qr[d0]=*reinterpret_cast<const bf16x8*>(&Qw[(long)r32*DM+d0*16+hi*8]);
  float mhat=0.f,l_reg=0.f;f32x16 o[2];o[0]=f32x16{};o[1]=f32x16{};const f32x16 negm=f32x16{};
  const int qrel=wid*QBLK+r32;
  #define CMASK(P0,P1,t) do{int jb_=(t)-(NT-4); if(jb_>=0)cmask(P0,P1,jb_,qrel,hi);}while(0)
  bool resc=false;
  #define START(P0,P1) do{ const float rm=rowmax(P0,P1); resc=false; \
    { const float dl=rm; mhat=fadd_s(mhat,dl); \
      _Pragma("unroll") for(int r=0;r<16;++r){P0[r]=fsub_s(P0[r],dl);P1[r]=fsub_s(P1[r],dl);} \
      } \
    _Pragma("unroll") for(int r=0;r<16;++r)P0[r]=mand(__builtin_amdgcn_exp2f(P0[r]),m0lo,BP(r)); }while(0)
  #define RESC() do{ if(resc){ asm volatile("s_waitcnt lgkmcnt(0)":::"memory"); \
      _Pragma("unroll") for(int d_=0;d_<2;++d_) _Pragma("unroll") for(int r=0;r<16;++r)o[d_][r]*=wsf[crow(r,hi)]; } }while(0)
  f32x16 pA0,pA1,pB0,pB1;
  int sl_prev=0,sl_cur=0,sl_next=SLOTB;
  #define ROT() do{sl_prev=sl_cur;sl_cur=sl_next;sl_next=(sl_next==(NSLOT-1)*SLOTB)?0:sl_next+SLOTB;}while(0)
  DMA_K(2,2*SLOTB);
  WAIT_BAR(3);
  qkt(pA0,pA1,Kbase,qr,negm,r32,hi);asm volatile("s_nop 15\n\ts_nop 7":"+v"(pA0),"+v"(pA1));CMASK(pA0,pA1,0);
  MRD(0,m0lo,m0hi);
  START(pA0,pA1);
  _Pragma("unroll") for(int r=0;r<16;++r)pA1[r]=mand(__builtin_amdgcn_exp2f(pA1[r]),m0hi,BP(r));
  WAIT_BAR(0);
  DMA_K(3,0);DMA_V(1,SLOTB);
  ROT();
  kload8(kf,kp0+sl_cur);
  WAIT_BAR(2);
  s16x4 vlo[8],vhi[8]; u32x4 pw0,pw1,pw2,pw3;
  #define PKW(P,B) cvtpk_s(P[B],P[B+1])
  #define PAF(k) __builtin_bit_cast(bf16x8,pw##k)
  #define VFR(i) (bf16x8){vlo[i][0],vlo[i][1],vlo[i][2],vlo[i][3],vhi[i][0],vhi[i][1],vhi[i][2],vhi[i][3]}
  #define PIN(x) asm volatile("":"+v"(x))
  #define MX3(a,b,c) __builtin_fmaxf(__builtin_fmaxf((a),(b)),(c))
  #define GAPA(MF,A0,A1,A2,A3,W0,W1,PW) do{ MF; sacc+=A0; sacc+=A1; sacc+=A2; sacc+=A3; PIN(sacc); W0; W1; PIN(PW); SBAR(); }while(0)
  #define EX(v) __builtin_amdgcn_exp2f(v)
  #define GAPB(MF,X,B,MW) do{ MF; X[B]=mand(EX(X[B]),(MW),BP(B)); X[B+1]=mand(EX(X[B+1]),(MW),BP(B+1)); X[B+2]=mand(EX(X[B+2]),(MW),BP(B+2)); X[B+3]=mand(EX(X[B+3]),(MW),BP(B+3)); PIN(X); SBAR(); }while(0)
  #define VRD(i) do{ vlo[i]=vtr(vp_+(((i)>>2)*4096+((i)&3)*1024)); vhi[i]=vtr(vp_+(((i)>>2)*4096+((i)&3)*1024+512)); }while(0)
  #define KRD(G,j) do{ if(G){ kload2(kf,kp0+sl_next,j); SBAR(); } }while(0)
  #define STEP(C0,C1,P0,P1,t,GK,GV,GL,MS) do{ SBAR(); MRD(MS,mlo_,mhi_); \
    const lds_cptr vp_=vp0+sl_prev; \
    VRD(0); SBAR(); float sacc=(P0[0]+P0[1]); \
    GAPA(C0=__builtin_amdgcn_mfma_f32_32x32x16_bf16(kf[0],qr[0],negm,0,0,0), P0[2],P0[3],P0[4],P0[5],     pw0[0]=PKW(P0,0), pw0[1]=PKW(P0,2), pw0); \
    VRD(4); SBAR(); GAPA(C1=__builtin_amdgcn_mfma_f32_32x32x16_bf16(kf[1],qr[0],negm,0,0,0), P0[6],P0[7],P0[8],P0[9],     pw0[2]=PKW(P0,4), pw0[3]=PKW(P0,6), pw0); \
    VRD(1); SBAR(); GAPA(C0=__builtin_amdgcn_mfma_f32_32x32x16_bf16(kf[2],qr[1],C0,0,0,0),   P0[10],P0[11],P0[12],P0[13], pw1[0]=PKW(P0,8), pw1[1]=PKW(P0,10), pw1); \
    VRD(5); SBAR(); GAPA(C1=__builtin_amdgcn_mfma_f32_32x32x16_bf16(kf[3],qr[1],C1,0,0,0),   P0[14],P0[15],P1[0],P1[1],   pw1[2]=PKW(P0,12),pw1[3]=PKW(P0,14), pw1); \
    VRD(2); SBAR(); GAPA(C0=__builtin_amdgcn_mfma_f32_32x32x16_bf16(kf[4],qr[2],C0,0,0,0),   P1[2],P1[3],P1[4],P1[5],     pw2[0]=PKW(P1,0), pw2[1]=PKW(P1,2), pw2); \
    VRD(6); SBAR(); GAPA(C1=__builtin_amdgcn_mfma_f32_32x32x16_bf16(kf[5],qr[2],C1,0,0,0),   P1[6],P1[7],P1[8],P1[9],     pw2[2]=PKW(P1,4), pw2[3]=PKW(P1,6), pw2); \
    VRD(3); SBAR(); GAPA(C0=__builtin_amdgcn_mfma_f32_32x32x16_bf16(kf[6],qr[3],C0,0,0,0),   P1[10],P1[11],P1[12],P1[13], pw3[0]=PKW(P1,8), pw3[1]=PKW(P1,10), pw3); \
    VRD(7); SBAR(); GAPA(C1=__builtin_amdgcn_mfma_f32_32x32x16_bf16(kf[7],qr[3],C1,0,0,0),   P1[14],P1[15],0.f,0.f,       pw3[2]=PKW(P1,12),pw3[3]=PKW(P1,14), pw3); \
    l_reg+=sacc; \
    if(GV){MDMA((t)+1,1-(MS));} if(GK){DMA_K((t)+3,sl_cur);} if(GV){DMA_V((t)+1,sl_next);} \
    _Pragma("unroll") for(int r=0;r<16;++r){C0[r]-=mhat;C1[r]-=mhat;} \
    CMASK(C0,C1,t); \
    { float a=MX3(C0[0],C0[1],C1[0]),b=MX3(C0[2],C0[3],C1[1]); a=MX3(a,C1[2],C1[3]); \
      _Pragma("unroll") for(int r=4;r<16;r+=4){a=MX3(a,C0[r],C0[r+1]);b=MX3(b,C0[r+2],C0[r+3]);a=MX3(a,C1[r],C1[r+1]);b=MX3(b,C1[r+2],C1[r+3]);} \
      float rm=__builtin_fmaxf(a,b); { auto rr=__builtin_amdgcn_permlane32_swap(__float_as_uint(rm),__float_as_uint(rm),false,false); rm=__builtin_fmaxf(__uint_as_float(rr[0]),__uint_as_float(rr[1])); } \
      resc=false; \
      if(__builtin_expect(__any(rm>(float)THRL),0)){ const float dl=__builtin_fmaxf(rm,0.f); mhat+=dl; \
        _Pragma("unroll") for(int r=0;r<16;++r){C0[r]-=dl;C1[r]-=dl;} \
        const float f=__builtin_amdgcn_exp2f(-dl); l_reg*=f; if(hi==0)wsf[r32]=f; resc=true; } } \
    SBAR(); \
    GAPB(o[0]=__builtin_amdgcn_mfma_f32_32x32x16_bf16(PAF(0),VFR(0),o[0],0,0,0), C0,0,mlo_); \
    GAPB(o[1]=__builtin_amdgcn_mfma_f32_32x32x16_bf16(PAF(0),VFR(4),o[1],0,0,0), C0,4,mlo_); \
    KRD(GL,0); GAPB(o[0]=__builtin_amdgcn_mfma_f32_32x32x16_bf16(PAF(1),VFR(1),o[0],0,0,0), C0,8,mlo_); \
    KRD(GL,1); GAPB(o[1]=__builtin_amdgcn_mfma_f32_32x32x16_bf16(PAF(1),VFR(5),o[1],0,0,0), C0,12,mlo_); \
    KRD(GL,2); GAPB(o[0]=__builtin_amdgcn_mfma_f32_32x32x16_bf16(PAF(2),VFR(2),o[0],0,0,0), C1,0,mhi_); \
    KRD(GL,3); GAPB(o[1]=__builtin_amdgcn_mfma_f32_32x32x16_bf16(PAF(2),VFR(6),o[1],0,0,0), C1,4,mhi_); \
    GAPB(o[0]=__builtin_amdgcn_mfma_f32_32x32x16_bf16(PAF(3),VFR(3),o[0],0,0,0), C1,8,mhi_); \
    GAPB(o[1]=__builtin_amdgcn_mfma_f32_32x32x16_bf16(PAF(3),VFR(7),o[1],0,0,0), C1,12,mhi_); \
    }while(0)
  int t=1;
  #undef CMASK
  #define CMASK(P0,P1,t) do{}while(0)
  for(;t+5<NT;t+=2){
    STEP(pB0,pB1,pA0,pA1,t,true,true,true,1);     WAIT_BAR(2); RESC(); ROT();
    STEP(pA0,pA1,pB0,pB1,t+1,true,true,true,0);   WAIT_BAR(2); RESC(); ROT();
  }
  #undef CMASK
  #define CMASK(P0,P1,t) do{int jb_=(t)-(NT-4); if(jb_>=0)cmask(P0,P1,jb_,qrel,hi);}while(0)
  #define ENDW(tt) do{ if((tt)+3<NT){WAIT_BAR(2);} else if((tt)+2<NT){WAIT_BAR(1);} else {WAIT_BAR(0);} }while(0)
  for(;t+1<NT;t+=2){
    STEP(pB0,pB1,pA0,pA1,t,(t+3<NT),(t+1<NT),(t+1<NT),1);       ENDW(t);   RESC(); ROT();
    STEP(pA0,pA1,pB0,pB1,t+1,(t+4<NT),(t+2<NT),(t+2<NT),0);     ENDW(t+1); RESC(); ROT();
  }
  STEP(pB0,pB1,pA0,pA1,NT-1,false,false,false,1); RESC();
  { float sacc=pB0[0]+pB0[1]; _Pragma("unroll") for(int r=2;r<16;++r)sacc+=pB0[r]; _Pragma("unroll") for(int r=0;r<16;++r)sacc+=pB1[r]; l_reg+=sacc;
    pw0=(u32x4){PKW(pB0,0),PKW(pB0,2),PKW(pB0,4),PKW(pB0,6)};pw1=(u32x4){PKW(pB0,8),PKW(pB0,10),PKW(pB0,12),PKW(pB0,14)};pw2=(u32x4){PKW(pB1,0),PKW(pB1,2),PKW(pB1,4),PKW(pB1,6)};pw3=(u32x4){PKW(pB1,8),PKW(pB1,10),PKW(pB1,12),PKW(pB1,14)};
    SBAR(); pv(o,vb0+sl_cur,PAF(0),PAF(1),PAF(2),PAF(3)); }
  #undef PKW
  #undef PAF
  #undef VFR
  #undef PIN
  #undef MX3
  #undef GAPA
  #undef GAPB
  #undef EX
  #undef VRD
  #undef KRD
  #undef STEP
  #undef ENDW
  {auto rr=__builtin_amdgcn_permlane32_swap(__float_as_uint(l_reg),__float_as_uint(l_reg),false,false);l_reg=__uint_as_float(rr[0])+__uint_as_float(rr[1]);}
  if(hi==0)wsf[32+r32]=l_reg;asm volatile("s_waitcnt lgkmcnt(0)":::"memory");
  float rli[16];
  #pragma unroll
  for(int r=0;r<16;++r)rli[r]=__builtin_amdgcn_rcpf(wsf[32+crow(r,hi)]);
  bf16*Ow=O+(rowbase+q0+wid*QBLK)*OPITCH+h*D;
  { bf16*stg=(bf16*)(shm+LDS_OST)+wid*2048;
    #pragma unroll
    for(int r=0;r<16;++r){const int orow=crow(r,hi);
      #pragma unroll
      for(int d0=0;d0<2;++d0)stg[orow*64+d0*32+r32]=__float2bfloat16(o[d0][r]*rli[r]);}
    asm volatile("s_waitcnt lgkmcnt(0)":::"memory");
    #pragma unroll
    for(int i=0;i<4;++i){const int row=i*8+(lane>>3),ch=lane&7; const u32x4 v=*(const u32x4*)(stg+row*64+ch*8); ATTN_STORE16(Ow+(long)row*OPITCH+ch*8,v);} }
  asm volatile("s_waitcnt lgkmcnt(0)\n\ts_barrier":::"memory");
  #undef DMA_K
  #undef DMA_V
  #undef CMASK
  #undef START
  #undef RESC
  #undef ROT
  #undef MDMA
  #undef MRD
  #undef BP
}
constexpr int ATTN_LDS_BYTES=LDS_BYTES;
struct AttnTensors { const bf16* Q; const bf16* K; const bf16* V; bf16* O; const unsigned long long* MK; };
struct AttnUnit { int bh; int qb; };
struct StaticOrder {
  int vcu, G;
  __device__ __forceinline__ explicit StaticOrder(int grid,int v):vcu(v),G(grid){}
  __device__ __forceinline__ bool next(int i,AttnUnit&u)const{ const int p=vcu+(i>>1)*G; if(p>=256)return false; const int s=p&7; u.bh=p>>3; u.qb=(i&1)?15-s:s; return true; }
  __device__ __forceinline__ void a_ready(const AttnUnit&)const{}
  __device__ __forceinline__ void done(const AttnUnit&)const{}
};
template<class Sched,int THRL=8> __device__ __forceinline__ void attn_phase(char*lds,const AttnTensors&T,const Sched&S,const int wid){
  AttnUnit u;
  for(int i=0;S.next(i,u);++i){ S.a_ready(u); attn_unit<THRL>(u.bh/NHEAD,u.bh%NHEAD,u.qb,T.Q,T.K,T.V,T.O,T.MK,lds,wid); S.done(u); }
}
#undef SBAR
#undef WAIT_BAR
}
constexpr int NWAVES = 8, NTHR = 512;
constexpr int NP = 16384, NSR = 512, M = NP + NSR;
constexpr int D = 1024, SEQ = 4096, NB = 4, NSQ = 128, TS = 4, PAST = 2048, PAGE = 128, NPAGES = 16;
constexpr int DFF = 2816, DFF2 = 5632, ECOLS = 2560, OCOLS = 2632, OCOLS_P = 2816, AW = 512, TOPK = 256;
constexpr float ALPHA = 1.4142135623730951f, LN_EPS = 1e-5f, ATT_SCALE = 0.125f;
constexpr int E_U = 0, E_V = 512, E_B = 1024, E_C = 1536, E_H = 2048;
constexpr int O_P = 0, O_Q = 512, O_K = 1024, O_V = 1536, O_QI = 2048, O_KI = 2560, O_WI = 2624;
constexpr size_t OUT_YP = 0, OUT_YS = OUT_YP + (size_t)NP * D, OUT_AV = OUT_YS + (size_t)NSR * D, OUT_BP = OUT_AV + (size_t)NSR * AW,
    OUT_BS = OUT_BP + (size_t)NB * 2 * 512, OUT_CP = OUT_BS + (size_t)NSQ * 2 * 512, OUT_CS = OUT_CP + (size_t)NB * 15 * 512, OUT_KP = OUT_CS + (size_t)NSQ * 15 * 512,
    OUT_VP = OUT_KP + (size_t)NP * 512, OUT_KIP = OUT_VP + (size_t)NP * 512, OUT_KS = OUT_KIP + (size_t)NP * 64, OUT_VS = OUT_KS + (size_t)NSR * 512,
    OUT_KIS = OUT_VS + (size_t)NSR * 512, OUT_FP = OUT_KIS + (size_t)NSR * 64, OUT_FS = OUT_FP + (size_t)2 * NB * 2 * DFF2, OUT_END = OUT_FS + (size_t)2 * NSQ * 2 * DFF2;
static_assert(OUT_END == 40069120, "output size");
constexpr size_t MiB = 1u << 20;
constexpr size_t WS_CTL = 0, CTL_ZERO_BYTES = 1 * MiB;
constexpr size_t WS_ROPE = 1 * MiB;
constexpr size_t WS_WSB = WS_ROPE + 512 * 1024;
constexpr size_t WS_WINE = 2 * MiB, WS_WOUTE = 7 * MiB, WS_WINO = 9 * MiB, WS_WOUTO = 15 * MiB, WS_WUP = 17 * MiB, WS_WDN = 39 * MiB;
constexpr size_t WUP_BYTES = (size_t)DFF2 * D * 2, WDN_BYTES = (size_t)D * DFF * 2;
static_assert(WS_WUP + 2 * WUP_BYTES <= WS_WDN && WS_WDN + 2 * WDN_BYTES <= 52 * MiB, "weights");
constexpr size_t WS_XB0 = 64 * MiB;
constexpr size_t WS_XF0 = 128 * MiB, WS_XF1 = 196 * MiB;
constexpr size_t WS_XBF0 = 264 * MiB, WS_XBF1 = 298 * MiB;
constexpr size_t WS_E0 = 512 * MiB;
constexpr size_t WS_PIN = 580 * MiB, WS_WI = 614 * MiB, WS_QRS = 616 * MiB, WS_QIS = 618 * MiB;
constexpr size_t WS_AO = 704 * MiB;
constexpr size_t WS_Y = 768 * MiB;
constexpr size_t WS_HU = 1024 * MiB;
constexpr size_t WS_G = 1408 * MiB;
constexpr size_t WS_SEL = 1680 * MiB, WS_NSEL = 1698 * MiB;
constexpr size_t WS_SC = 1700 * MiB;
constexpr size_t WS_QB = 1770 * MiB, WS_KB = 1788 * MiB, WS_VB = 1806 * MiB, WS_QIB = 1824 * MiB, WS_KIB = 1842 * MiB;
constexpr size_t WS_MASK = 1846 * MiB;
constexpr size_t WS_END = 1856 * MiB;
constexpr int CW_BAR = 4096;
constexpr int RING_BYTES = 135168, LDSCTL_OFF = RING_BYTES, MISC_OFF = LDSCTL_OFF + 320, ITAB_OFF = LDSCTL_OFF + 512, LDS_BYTES = 147456;

#define GAS __attribute__((address_space(1)))
#define LAS __attribute__((address_space(3)))
typedef unsigned short bf16;
typedef unsigned v4u __attribute__((ext_vector_type(4)));
typedef unsigned v2u __attribute__((ext_vector_type(2)));
typedef float f32x4 __attribute__((ext_vector_type(4)));
typedef GAS unsigned gu32;
#define RLX_AGENT __ATOMIC_RELAXED, __HIP_MEMORY_SCOPE_AGENT
#define LDS_WAIT() asm volatile("s_waitcnt lgkmcnt(0)" ::: "memory")
#define VM_WAIT() asm volatile("s_waitcnt vmcnt(0)" ::: "memory")
__device__ __forceinline__ unsigned f2bf(float f) { unsigned u = __builtin_bit_cast(unsigned, f); return (u + 0x7fffu + ((u >> 16) & 1u)) >> 16; }
__device__ __forceinline__ unsigned pk2(float lo, float hi) { return f2bf(lo) | (f2bf(hi) << 16); }
__device__ __forceinline__ float gelu_t(float x) { const float t = x * (1.f + 0.044715f * x * x); const float e = __builtin_amdgcn_exp2f(-2.302208198f * t); return x / (1.f + e); }
__device__ __forceinline__ float silu_f(float x) { const float e = __builtin_amdgcn_exp2f(-1.4426950408889634f * x); return x / (1.f + e); }
__device__ __forceinline__ float wave_sum(float v) {
#pragma unroll
    for (int o = 1; o < 64; o <<= 1) v += __shfl_xor(v, o);
    return v;
}
#define XB_TMO      128
#define XB_XCNT(j)  (256  + 64 * (j))
#define XB_XSUB(j)  (1280 + 64 * (j))
#define XB_XGEN(j)  (2304 + 64 * (j))
#define XB_TOP      3328
#define XB_TOPGEN   3392
#define XCD_BAR_WORDS 3456
#define XB_SPIN_CAP (1u << 18)

__device__ __forceinline__ unsigned xb_ld(unsigned* p)              { return __hip_atomic_load(p, __ATOMIC_RELAXED, __HIP_MEMORY_SCOPE_AGENT); }
__device__ __forceinline__ unsigned xb_add(unsigned* p, unsigned v) { return __hip_atomic_fetch_add(p, v, __ATOMIC_RELAXED, __HIP_MEMORY_SCOPE_AGENT); }
__device__ __forceinline__ unsigned xb_xcc_id() { return (unsigned)__builtin_amdgcn_s_getreg((3 << 11) | 20) & 0xFu; }
#define XB_SPIN(cond, bar) do { unsigned _sp = 0; while (cond) { __builtin_amdgcn_s_sleep(1); \
    if ((++_sp & 255u) == 0u) { if (xb_ld(&(bar)[XB_TMO])) break; if (_sp > XB_SPIN_CAP) { atomicAdd(&(bar)[XB_TMO], 1u); break; } } } } while (0)

struct XcdBarrier {
    unsigned* bar; unsigned x;
    volatile LAS unsigned* st;
};

__device__ __forceinline__ XcdBarrier xcd_barrier_post(unsigned* bar, volatile LAS unsigned* st, const bool t0) {
    XcdBarrier b; b.bar = bar; b.x = xb_xcc_id(); b.st = st;
    if (t0) (void)xb_add(&bar[XB_XCNT(b.x)], 1u);
    return b;
}
__device__ __forceinline__ void xcd_barrier_complete(unsigned* bar, unsigned x, unsigned& nloc, unsigned& nx) {
    const unsigned G = gridDim.x * gridDim.y * gridDim.z;
    unsigned sum, cnt, mine, sp = 0u;
    for (;;) {
        sum = 0u; cnt = 0u; mine = 0u;
#pragma unroll
        for (unsigned j = 0; j < 16; ++j) { const unsigned c = xb_ld(&bar[XB_XCNT(j)]); sum += c; cnt += (c > 0u) ? 1u : 0u; mine = (j == x) ? c : mine; }
        if (sum == G) break;
        __builtin_amdgcn_s_sleep(1);
        if ((++sp & 255u) == 0u) { if (xb_ld(&bar[XB_TMO])) break; if (sp > XB_SPIN_CAP) { atomicAdd(&bar[XB_TMO], 1u); break; } }
    }
    nloc = mine > 0u ? mine : 1u; nx = cnt > 0u ? cnt : 1u;
}

__device__ __forceinline__ void xcd_barrier(const XcdBarrier& b, const bool t0) {
    asm volatile("s_waitcnt vmcnt(0)" ::: "memory");
    __syncthreads();
    if (t0) {
        unsigned* bar = b.bar;
        __builtin_amdgcn_s_waitcnt(0);
        unsigned nloc = b.st[0], nx = b.st[1];
        if (nloc == 0u) { xcd_barrier_complete(bar, b.x, nloc, nx); b.st[0] = nloc; b.st[1] = nx; }
        const unsigned old = xb_add(&bar[XB_XSUB(b.x)], 1u);
        const unsigned gen = old / nloc;
        if (old + 1u == (gen + 1u) * nloc) {
            __builtin_amdgcn_fence(__ATOMIC_RELEASE, "agent");
            asm volatile("s_waitcnt vmcnt(0)" ::: "memory");
            const unsigned og = xb_add(&bar[XB_TOP], 1u);
            const unsigned tg = og / nx;
            if (og + 1u == (tg + 1u) * nx) xb_add(&bar[XB_TOPGEN], 1u);
            else XB_SPIN(xb_ld(&bar[XB_TOPGEN]) == tg, bar);
            __builtin_amdgcn_fence(__ATOMIC_ACQUIRE, "agent");
            xb_add(&bar[XB_XGEN(b.x)], 1u);
            asm volatile("s_waitcnt vmcnt(0)" ::: "memory");
        } else {
            XB_SPIN(xb_ld(&bar[XB_XGEN(b.x)]) == gen, bar);
            __builtin_amdgcn_fence(__ATOMIC_ACQUIRE, "agent");
            asm volatile("s_waitcnt vmcnt(0)" ::: "memory");
        }
    }
    __syncthreads();
}
struct Frame {
    LAS unsigned char* lds;
    volatile LAS unsigned* MISC;
    gu32* ctl;
    int tid, lane, wave, vcu, G;
    const LAS unsigned long long* itab;
    float* out; unsigned char* ws;
};
__device__ __forceinline__ const float* inp_ptr(const Frame& F, int i) { const unsigned long long v = F.itab[i]; const unsigned lo = __builtin_amdgcn_readfirstlane((unsigned)v), hi = __builtin_amdgcn_readfirstlane((unsigned)(v >> 32)); return (const float*)(((unsigned long long)hi << 32) | lo); }
#define INP(i) inp_ptr(F, (i))
__device__ __forceinline__ const float* xrow_in(const Frame& F, int r) { return r < NP ? INP(0) + (size_t)r * D : INP(1) + (size_t)(r - NP) * D; }

template <bool PERMUTE = false>
__device__ __forceinline__ void p0_transpose_item(const float* W, int K, int N, int nblk, bf16* WT, LAS float* scr, int item, int lane) {
    const int kb = item / nblk, nb = item % nblk, k0 = 64 * kb, n0 = 32 * nb;
    int nn = n0 + (lane & 31);
    if (PERMUTE && nn >= 1536) { const int rem = nn - 1536; nn = ((rem & 128) ? E_H : E_C) + 128 * (rem >> 8) + (rem & 127); }
#pragma unroll 8
    for (int i = 0; i < 32; ++i) { const int kk = 2 * i + (lane >> 5); scr[kk * 33 + (lane & 31)] = (nn < N) ? W[(size_t)(k0 + kk) * N + nn] : 0.f; }
    LDS_WAIT(); asm volatile("" ::: "memory");
    const int c = lane & 7;
#pragma unroll
    for (int j = 0; j < 4; ++j) { const int n = (lane >> 3) + 8 * j; const LAS float* s = scr + (8 * c) * 33 + n;
        v4u o; o.x = pk2(s[0 * 33], s[1 * 33]); o.y = pk2(s[2 * 33], s[3 * 33]); o.z = pk2(s[4 * 33], s[5 * 33]); o.w = pk2(s[6 * 33], s[7 * 33]);
        *(GAS v4u*)(WT + (size_t)(n0 + n) * K + k0 + 8 * c) = o; }
    LDS_WAIT(); asm volatile("" ::: "memory");
}
__device__ __forceinline__ void p0_prologue(Frame& F) {
    LAS float* scr = (LAS float*)(F.lds + F.wave * 16384);
    const int gw = F.vcu * NWAVES + F.wave, NGW = F.G * NWAVES;
    constexpr int I_INE = 16 * 80, I_SQ = 16 * 32, I_INO = 16 * 88, I_UP = 16 * 176, I_DN = 44 * 32;
    constexpr int I_HSQ = 8 * 32, I_FOLD = 4 * 16 * 8;
    constexpr int NITEMS = I_INE + I_SQ + I_INO + I_HSQ + 2 * I_UP + 2 * I_DN + I_FOLD;
    for (int it = gw; it < NITEMS; it += NGW) {
        int r = it;
        if (r < I_INE) { p0_transpose_item<true>(INP(9), D, ECOLS, 80, (bf16*)(F.ws + WS_WINE), scr, r, F.lane); continue; } r -= I_INE;
        if (r < I_SQ) { p0_transpose_item(INP(15), D, D, 32, (bf16*)(F.ws + WS_WOUTE), scr, r, F.lane); continue; } r -= I_SQ;
        if (r < I_INO) { p0_transpose_item(INP(16), D, OCOLS, 88, (bf16*)(F.ws + WS_WINO), scr, r, F.lane); continue; } r -= I_INO;
        if (r < I_HSQ) { p0_transpose_item(INP(19), D, D, 32, (bf16*)(F.ws + WS_WOUTO), scr, r + I_HSQ, F.lane); continue; } r -= I_HSQ;
        if (r < 2 * I_UP) { const int l = r / I_UP; p0_transpose_item(INP(22) + (size_t)l * D * DFF2, D, DFF2, 176, (bf16*)(F.ws + WS_WUP + l * WUP_BYTES), scr, r % I_UP, F.lane); continue; } r -= 2 * I_UP;
        if (r < 2 * I_DN) { const int l = r / I_DN; p0_transpose_item(INP(25) + (size_t)l * DFF * D, DFF, D, 32, (bf16*)(F.ws + WS_WDN + l * WDN_BYTES), scr, r % I_DN, F.lane); continue; } r -= 2 * I_DN;
        {
            const int g = r >> 7, nb = (r >> 3) & 15, cb = r & 7, n = nb * 64 + F.lane;
            const float* cw = INP(17) + (size_t)(g * 128 + cb * 16) * 128; const float* cs = INP(18) + g * 128; const float* wo = INP(19) + (size_t)(g * 128) * D + n;
            float acc[16];
#pragma unroll
            for (int ci = 0; ci < 16; ++ci) acc[ci] = 0.f;
            for (int d = 0; d < 128; ++d) { const float wvv = cs[d] * wo[(size_t)d * D];
#pragma unroll
                for (int ci = 0; ci < 16; ++ci) acc[ci] += cw[ci * 128 + d] * wvv; }
            bf16* o = (bf16*)(F.ws + WS_WOUTO) + (size_t)n * D + g * 128 + cb * 16;
            *(v4u*)o = (v4u){pk2(acc[0], acc[1]), pk2(acc[2], acc[3]), pk2(acc[4], acc[5]), pk2(acc[6], acc[7])}; *(v4u*)(o + 8) = (v4u){pk2(acc[8], acc[9]), pk2(acc[10], acc[11]), pk2(acc[12], acc[13]), pk2(acc[14], acc[15])};
        }
    }
    bf16* XB = (bf16*)(F.ws + WS_XB0);
    for (int r = gw; r < M; r += NGW) {
        const f32x4* xr = (const f32x4*)xrow_in(F, r) + F.lane;
        unsigned long long* o8 = (unsigned long long*)(XB + (size_t)r * D) + F.lane;
#pragma unroll
        for (int j = 0; j < 4; ++j) { const f32x4 v = xr[64 * j]; o8[64 * j] = (unsigned long long)pk2(v.x, v.y) | ((unsigned long long)pk2(v.z, v.w) << 32); }
    }
    { const float* aws = INP(12); bf16* wsb = (bf16*)(F.ws + WS_WSB);
      for (int e = F.vcu * NTHR + F.tid; e < 4 * 128 * 128; e += F.G * NTHR) { const int s_ = e & 127, t_ = (e >> 7) & 127; wsb[e] = (bf16)f2bf(s_ <= t_ ? aws[e] : 0.f); } }
    {
        float* ct = (float*)(F.ws + WS_ROPE); float* st = ct + 4096 * 8;
        const int gt = F.vcu * NTHR + F.tid;
        if (gt < 4096 * 8) {
            const int pos = gt >> 3, i = gt & 7;
            const float invs[8] = {1.0f, 0.1939227432012558f, 0.03760603070259094f, 0.007292664609849453f, 0.0014142135623842478f, 0.00027424818836152554f, 5.318296098266728e-05f, 1.0313386155758053e-05f};
            float inv = invs[0];
#pragma unroll
            for (int k = 1; k < 8; ++k) inv = (i == k) ? invs[k] : inv;
            const float angf = (float)pos * inv;
            const double a = (double)angf;
            const double n = __builtin_rint(a * 0.15915494309189535);
            double x = __builtin_fma(-n, 6.283185307179586, a); x = __builtin_fma(-n, 2.4492935982947064e-16, x);
            const double x2 = x * x;
            double sn = 1.0 / 51090942171709440000.0;
            sn = sn * x2 - 1.0 / 121645100408832000.0; sn = sn * x2 + 1.0 / 355687428096000.0; sn = sn * x2 - 1.0 / 1307674368000.0; sn = sn * x2 + 1.0 / 6227020800.0;
            sn = sn * x2 - 1.0 / 39916800.0; sn = sn * x2 + 1.0 / 362880.0; sn = sn * x2 - 1.0 / 5040.0; sn = sn * x2 + 1.0 / 120.0; sn = sn * x2 - 1.0 / 6.0; sn = sn * x2 + 1.0; sn = sn * x;
            double cs = 1.0 / 2432902008176640000.0;
            cs = cs * x2 - 1.0 / 6402373705728000.0; cs = cs * x2 + 1.0 / 20922789888000.0; cs = cs * x2 - 1.0 / 87178291200.0; cs = cs * x2 + 1.0 / 479001600.0;
            cs = cs * x2 - 1.0 / 3628800.0; cs = cs * x2 + 1.0 / 40320.0; cs = cs * x2 - 1.0 / 720.0; cs = cs * x2 + 1.0 / 24.0; cs = cs * x2 - 0.5; cs = cs * x2 + 1.0;
            ct[gt] = (float)cs; st[gt] = (float)sn;
        }
    }
}

__device__ __forceinline__ void ln_phase(Frame& F, const float* Z, const float* g, const float* b, float* outF, bf16* outB) {
    const int gw = F.vcu * NWAVES + F.wave, NGW = F.G * NWAVES;
    f32x4 gv[4], bv[4];
#pragma unroll
    for (int j = 0; j < 4; ++j) { gv[j] = *((const f32x4*)g + F.lane + 64 * j); bv[j] = *((const f32x4*)b + F.lane + 64 * j); }
    for (int r = gw; r < M; r += NGW) {
        const f32x4* zr = (const f32x4*)(Z + (size_t)r * D) + F.lane;
        f32x4 v[4]; float s = 0.f;
#pragma unroll
        for (int j = 0; j < 4; ++j) { v[j] = zr[64 * j]; s += (v[j].x + v[j].y) + (v[j].z + v[j].w); }
        const float mean = wave_sum(s) * (1.f / D); float s2 = 0.f;
#pragma unroll
        for (int j = 0; j < 4; ++j) { v[j] = v[j] - mean; s2 += (v[j].x * v[j].x + v[j].y * v[j].y) + (v[j].z * v[j].z + v[j].w * v[j].w); }
        const float rstd = 1.f / sqrtf(wave_sum(s2) * (1.f / D) + LN_EPS);
        f32x4* of = (f32x4*)(outF + (size_t)r * D) + F.lane;
#pragma unroll
        for (int j = 0; j < 4; ++j) { v[j] = v[j] * rstd * gv[j] + bv[j]; of[64 * j] = v[j]; }
        if (outB) { unsigned long long* o8 = (unsigned long long*)(outB + (size_t)r * D) + F.lane;
#pragma unroll
            for (int j = 0; j < 4; ++j) o8[64 * j] = (unsigned long long)pk2(v[j].x, v[j].y) | ((unsigned long long)pk2(v[j].z, v[j].w) << 32); }
    }
}
__device__ __forceinline__ float gelu_e(float x) { const float t = x * (1.f + 0.044715f * x * x); const float e = __builtin_amdgcn_exp2f(-2.302208198f * t); return x * __builtin_amdgcn_rcpf(1.f + e); }
__device__ __forceinline__ f32x4 gelu4(const f32x4& v) { return (f32x4){gelu_e(v.x), gelu_e(v.y), gelu_e(v.z), gelu_e(v.w)}; }
__device__ __forceinline__ v4u pack8(const f32x4& a, const f32x4& b) { return (v4u){pg8::cvt_pk_bf16(a.x, a.y), pg8::cvt_pk_bf16(a.z, a.w), pg8::cvt_pk_bf16(b.x, b.y), pg8::cvt_pk_bf16(b.z, b.w)}; }
constexpr int E0P = 2048;
struct EpiInEven {
    static constexpr bool PERM = true, AFTER_DRAIN = false;
    bf16* E0; float* out;
    __device__ __forceinline__ void operator()(const f32x4 (&acc)[2][2][4][2], const pg8::Unit& u, int wr, int wc, int fr, int fq) const {
        const int row0 = u.pm * 256 + wr * 64 + fr, cw = wc * 32 + 8 * fq;
        if (u.pn < 6) {
            const bool act = u.pn < 4;
#pragma unroll
            for (int ai = 0; ai < 2; ++ai)
#pragma unroll
                for (int m = 0; m < 4; ++m) { bf16* rowp = E0 + (size_t)(row0 + ai * 128 + m * 16) * E0P + u.pn * 256 + cw;
#pragma unroll
                    for (int bj = 0; bj < 2; ++bj) { f32x4 v0 = acc[ai][bj][m][0], v1 = acc[ai][bj][m][1]; if (act) { v0 = gelu4(v0); v1 = gelu4(v1); } *(v4u*)(rowp + bj * 128) = pack8(v0, v1); } }
        } else {
            const int k = u.pn - 6, cc = 128 * k + cw;
#pragma unroll
            for (int ai = 0; ai < 2; ++ai)
#pragma unroll
                for (int m = 0; m < 4; ++m) { const int r = row0 + ai * 128 + m * 16;
                    const f32x4 p0 = acc[ai][0][m][0] * acc[ai][1][m][0], p1 = acc[ai][0][m][1] * acc[ai][1][m][1];
                    *(v4u*)(E0 + (size_t)r * E0P + 1536 + cc) = pack8(p0, p1);
                    if (r < NP) { const int t = r & (SEQ - 1); if (t >= SEQ - 2) { float* o = out + OUT_BP + (size_t)((r >> 12) * 2 + (t - (SEQ - 2))) * 512 + cc; *(f32x4*)o = p0; *(f32x4*)(o + 4) = p1; } }
                    else { const int ts = (r - NP) & 3; if (ts >= 2) { float* o = out + OUT_BS + (size_t)(((r - NP) >> 2) * 2 + (ts - 2)) * 512 + cc; *(f32x4*)o = p0; *(f32x4*)(o + 4) = p1; } } }
        }
    }
};
struct EpiRes {
    static constexpr bool PERM = true, AFTER_DRAIN = false;
    const float* resP; const float* resS; float* Z;
    __device__ __forceinline__ void operator()(const f32x4 (&acc)[2][2][4][2], const pg8::Unit& u, int wr, int wc, int fr, int fq) const {
        const int row0 = u.pm * 256 + wr * 64 + fr, col0 = u.pn * 256 + wc * 32 + 8 * fq;
#pragma unroll
        for (int ai = 0; ai < 2; ++ai)
#pragma unroll
            for (int m = 0; m < 4; ++m) { const int r = row0 + ai * 128 + m * 16;
                const float* rp = (r < NP ? resP + (size_t)r * D : resS + (size_t)(r - NP) * D) + col0; float* zp = Z + (size_t)r * D + col0;
#pragma unroll
                for (int bj = 0; bj < 2; ++bj) { *(f32x4*)(zp + bj * 128) = *(const f32x4*)(rp + bj * 128) * ALPHA + acc[ai][bj][m][0]; *(f32x4*)(zp + bj * 128 + 4) = *(const f32x4*)(rp + bj * 128 + 4) * ALPHA + acc[ai][bj][m][1]; } }
    }
};
struct EpiUp {
    static constexpr bool PERM = true, AFTER_DRAIN = false;
    bf16* HU; float* out; int layer;
    __device__ __forceinline__ void operator()(const f32x4 (&acc)[2][2][4][2], const pg8::Unit& u, int wr, int wc, int fr, int fq) const {
        const int row0 = u.pm * 256 + wr * 64 + fr, col0 = u.pn * 256 + wc * 32 + 8 * fq;
#pragma unroll
        for (int ai = 0; ai < 2; ++ai)
#pragma unroll
            for (int m = 0; m < 4; ++m) { const int r = row0 + ai * 128 + m * 16; bf16* hp = HU + (size_t)r * DFF2 + col0;
#pragma unroll
                for (int bj = 0; bj < 2; ++bj) *(v4u*)(hp + bj * 128) = pack8(acc[ai][bj][m][0], acc[ai][bj][m][1]);
                float* o = nullptr;
                if (r < NP) { const int t = r & (SEQ - 1); if (t >= SEQ - 2) o = out + OUT_FP + ((size_t)(layer * NB + (r >> 12)) * 2 + (t - (SEQ - 2))) * DFF2 + col0; }
                else { const int ts = (r - NP) & 3; if (ts >= 2) o = out + OUT_FS + ((size_t)(layer * NSQ + ((r - NP) >> 2)) * 2 + (ts - 2)) * DFF2 + col0; }
                if (o) {
#pragma unroll
                    for (int bj = 0; bj < 2; ++bj) { *(f32x4*)(o + bj * 128) = acc[ai][bj][m][0]; *(f32x4*)(o + bj * 128 + 4) = acc[ai][bj][m][1]; } } }
    }
};
struct EpiInOdd {
    static constexpr bool PERM = true, AFTER_DRAIN = false;
    float* PIN; bf16* QB; bf16* KB; bf16* VB; bf16* QIB; bf16* KIB; float* WI; float* QRS; float* QIS; float* out; const float* ct; const float* st;
    __device__ __forceinline__ void operator()(const f32x4 (&acc)[2][2][4][2], const pg8::Unit& u, int wr, int wc, int fr, int fq) const {
        const int row0 = u.pm * 256 + wr * 64 + fr, cw = wc * 32 + 8 * fq, pn = u.pn;
        const bool rope = (pn >= 2 && pn != 6 && pn != 7) && ((wc & 1) == 0) && (pn < 10 || wc == 0);
        const float QSC = 0.125f * 1.4426950408889634f;
#pragma unroll
        for (int ai = 0; ai < 2; ++ai)
#pragma unroll
            for (int m = 0; m < 4; ++m) {
                const int r = row0 + ai * 128 + m * 16; const bool smp = r >= NP; const int rs = r - NP;
                f32x4 v[2][2];
#pragma unroll
                for (int bj = 0; bj < 2; ++bj) { v[bj][0] = acc[ai][bj][m][0]; v[bj][1] = acc[ai][bj][m][1]; }
                if (rope) {
                    const int pos = smp ? PAST + (rs & 3) : (r & (SEQ - 1));
                    f32x4 c0 = {1.f, 1.f, 1.f, 1.f}, c1 = c0, s0 = {0.f, 0.f, 0.f, 0.f}, s1 = s0;
                    if (fq < 2) { c0 = *(const f32x4*)(ct + pos * 8); c1 = *(const f32x4*)(ct + pos * 8 + 4); s0 = *(const f32x4*)(st + pos * 8); s1 = *(const f32x4*)(st + pos * 8 + 4); if (fq == 0) { s0 = -s0; s1 = -s1; } }
#pragma unroll
                    for (int bj = 0; bj < 2; ++bj) {
                        f32x4 o0, o1;
                        o0.x = __shfl_xor(v[bj][0].x, 16); o0.y = __shfl_xor(v[bj][0].y, 16); o0.z = __shfl_xor(v[bj][0].z, 16); o0.w = __shfl_xor(v[bj][0].w, 16);
                        o1.x = __shfl_xor(v[bj][1].x, 16); o1.y = __shfl_xor(v[bj][1].y, 16); o1.z = __shfl_xor(v[bj][1].z, 16); o1.w = __shfl_xor(v[bj][1].w, 16);
                        if (fq < 2 && (pn < 10 || bj == 0)) { v[bj][0] = v[bj][0] * c0 + o0 * s0; v[bj][1] = v[bj][1] * c1 + o1 * s1; }
                    }
                }
                if (pn < 2) {
#pragma unroll
                    for (int bj = 0; bj < 2; ++bj) { float* p = PIN + (size_t)r * 512 + pn * 256 + bj * 128 + cw; *(f32x4*)p = v[bj][0]; *(f32x4*)(p + 4) = v[bj][1]; }
                } else if (pn < 10) {
                    const int kind = (pn - 2) >> 1, cb = ((pn - 2) & 1) * 256 + cw;
                    bf16* dstb = (kind == 0 ? QB : kind == 1 ? KB : kind == 2 ? VB : QIB) + (size_t)r * 512 + cb;
                    const float sc = (kind == 0) ? QSC : 1.f;
#pragma unroll
                    for (int bj = 0; bj < 2; ++bj) *(v4u*)(dstb + bj * 128) = pack8(v[bj][0] * sc, v[bj][1] * sc);
                    float* fo = nullptr;
                    if (kind == 1) fo = smp ? out + OUT_KS + (size_t)rs * 512 + cb : out + OUT_KP + (size_t)r * 512 + cb;
                    else if (kind == 2) fo = smp ? out + OUT_VS + (size_t)rs * 512 + cb : out + OUT_VP + (size_t)r * 512 + cb;
                    else if (smp) fo = (kind == 0 ? QRS : QIS) + (size_t)rs * 512 + cb;
                    if (fo) {
#pragma unroll
                        for (int bj = 0; bj < 2; ++bj) { *(f32x4*)(fo + bj * 128) = v[bj][0]; *(f32x4*)(fo + bj * 128 + 4) = v[bj][1]; } }
                } else {
                    if (wc < 2) { *(v4u*)(KIB + (size_t)r * 64 + cw) = pack8(v[0][0], v[0][1]);
                        float* fo = smp ? out + OUT_KIS + (size_t)rs * 64 + cw : out + OUT_KIP + (size_t)r * 64 + cw; *(f32x4*)fo = v[0][0]; *(f32x4*)(fo + 4) = v[0][1]; }
                    else if (wc == 2 && fq == 0) { float* fo = WI + (size_t)r * 8; *(f32x4*)fo = v[0][0]; *(f32x4*)(fo + 4) = v[0][1]; }
                }
            }
    }
};
__device__ __forceinline__ f32x4 ld4bf(const bf16* p) { const v2u w = *(const v2u*)p; return (f32x4){__uint_as_float(w.x << 16), __uint_as_float(w.x & 0xffff0000u), __uint_as_float(w.y << 16), __uint_as_float(w.y & 0xffff0000u)}; }
__device__ __forceinline__ float ld1bf(const bf16* p) { return __uint_as_float((unsigned)(*p) << 16); }
__device__ __forceinline__ void p2_mixer_even(Frame& F) {
    const bf16* E0 = (const bf16*)(F.ws + WS_E0);
    bf16* AO = (bf16*)(F.ws + WS_AO);
    const float* a_g = INP(10); const float* a_b = INP(11); const float* a_ws = INP(12); const float* a_bs = INP(13); const float* bcw = INP(14);
    LAS float* Vn = (LAS float*)F.lds;
    LAS bf16* VT = (LAS bf16*)F.lds; constexpr int VTP = 136;
    const bf16* WsB = (const bf16*)(F.ws + WS_WSB);
    typedef short bf16x8v __attribute__((ext_vector_type(8)));
    for (int u = F.vcu; u < 512 + NSQ; u += F.G) {
        if (u < 512) {
            const int g = u & 3, chunk = (u >> 2) & 31, b = u >> 7, R0 = b * SEQ + chunk * 128;
#pragma unroll 2
            for (int i = 0; i < 16; ++i) {
                const int s = F.wave * 16 + i; const bf16* hp = E0 + (size_t)(R0 + s) * E0P + 512 + 8 * F.lane;
                const f32x4 a = ld4bf(hp), c = ld4bf(hp + 4);
                float x[8] = {a.x, a.y, a.z, a.w, c.x, c.y, c.z, c.w};
                float sm = 0.f;
#pragma unroll
                for (int k = 0; k < 8; ++k) sm += x[k];
                const float mean = wave_sum(sm) * (1.f / AW); float s2 = 0.f;
#pragma unroll
                for (int k = 0; k < 8; ++k) { x[k] -= mean; s2 += x[k] * x[k]; }
                const float rstd = 1.f / sqrtf(wave_sum(s2) * (1.f / AW) + LN_EPS);
                if ((F.lane >> 4) == g) {
                    const int c0 = 8 * F.lane;
#pragma unroll
                    for (int k = 0; k < 8; ++k) VT[(c0 - 128 * g + k) * VTP + s] = (bf16)f2bf(x[k] * rstd * a_g[c0 + k] + a_b[c0 + k]);
                }
            }
            __syncthreads();
            {
                const int fr = F.lane & 15, fq = F.lane >> 4, t0 = 16 * F.wave, nks = ((t0 + 15) >> 5) + 1, t = t0 + fr;
                bf16x8v Bw[4];
#pragma unroll
                for (int ks = 0; ks < 4; ++ks) if (ks < nks) Bw[ks] = *(const bf16x8v*)(WsB + (size_t)(g * 128 + t) * 128 + 32 * ks + 8 * fq);
                const float bs = a_bs[g * 128 + t]; const size_t r = (size_t)(R0 + t);
#pragma unroll 2
                for (int ct = 0; ct < 8; ++ct) {
                    f32x4 acc = {0.f, 0.f, 0.f, 0.f};
#pragma unroll
                    for (int ks = 0; ks < 4; ++ks) if (ks < nks) { const bf16x8v A = *(const LAS bf16x8v*)(VT + (16 * ct + fr) * VTP + 32 * ks + 8 * fq); acc = __builtin_amdgcn_mfma_f32_16x16x32_bf16(A, Bw[ks], acc, 0, 0, 0); }
                    const int col = g * 128 + 16 * ct + 4 * fq;
                    const f32x4 uu = ld4bf(E0 + r * E0P + col);
                    *(v2u*)(AO + r * D + col) = (v2u){pk2(uu.x * (acc.x + bs), uu.y * (acc.y + bs)), pk2(uu.z * (acc.z + bs), uu.w * (acc.w + bs))};
                }
            }
            const int c4 = F.tid & 31, col = g * 128 + 4 * c4;
            const f32x4 w0 = *(const f32x4*)(bcw + col), w1 = *(const f32x4*)(bcw + 512 + col), w2 = *(const f32x4*)(bcw + 1024 + col);
#pragma unroll 2
            for (int i = 0; i < 8; ++i) {
                const int t = (F.tid >> 5) + 16 * i; const size_t r = (size_t)(R0 + t);
                const int tt = chunk * 128 + t;
                const f32x4 p0 = ld4bf(E0 + r * E0P + 1536 + col);
                f32x4 p1 = {0.f, 0.f, 0.f, 0.f}, p2 = {0.f, 0.f, 0.f, 0.f};
                if (tt >= 1) p1 = ld4bf(E0 + (r - 1) * E0P + 1536 + col);
                if (tt >= 2) p2 = ld4bf(E0 + (r - 2) * E0P + 1536 + col);
                const f32x4 bo = ld4bf(E0 + r * E0P + 1024 + col) * (w2 * p0 + w1 * p1 + w0 * p2);
                *(v2u*)(AO + r * D + 512 + col) = (v2u){pk2(bo.x, bo.y), pk2(bo.z, bo.w)};
            }
            __syncthreads();
        } else {
            const int n = u - 512, R0 = NP + 4 * n;
            if (F.wave < 4) {
                const int t = F.wave; const bf16* hp = E0 + (size_t)(R0 + t) * E0P + 512 + 8 * F.lane;
                const f32x4 a = ld4bf(hp), c = ld4bf(hp + 4);
                float x[8] = {a.x, a.y, a.z, a.w, c.x, c.y, c.z, c.w};
                float sm = 0.f;
#pragma unroll
                for (int k = 0; k < 8; ++k) sm += x[k];
                const float mean = wave_sum(sm) * (1.f / AW); float s2 = 0.f;
#pragma unroll
                for (int k = 0; k < 8; ++k) { x[k] -= mean; s2 += x[k] * x[k]; }
                const float rstd = 1.f / sqrtf(wave_sum(s2) * (1.f / AW) + LN_EPS);
                const int c0 = 8 * F.lane;
#pragma unroll
                for (int k = 0; k < 8; ++k) { const float v = x[k] * rstd * a_g[c0 + k] + a_b[c0 + k]; Vn[t * 512 + c0 + k] = v; F.out[OUT_AV + (size_t)(n * 4 + t) * AW + c0 + k] = v; }
            }
            __syncthreads();
            {
                const int c = F.tid, g = c >> 7;
                float ext[6]; ext[0] = INP(2)[(size_t)(n * 2 + 0) * 512 + c]; ext[1] = INP(2)[(size_t)(n * 2 + 1) * 512 + c];
#pragma unroll
                for (int t = 0; t < 4; ++t) ext[2 + t] = ld1bf(E0 + (size_t)(R0 + t) * E0P + 1536 + c);
                const float w0 = bcw[c], w1 = bcw[512 + c], w2 = bcw[1024 + c];
#pragma unroll
                for (int t = 0; t < 4; ++t) {
                    float mix = a_bs[g * 128 + t];
#pragma unroll
                    for (int s = 0; s <= t; ++s) mix += a_ws[(size_t)(g * 128 + t) * 128 + s] * Vn[s * 512 + c];
                    const float ao = ld1bf(E0 + (size_t)(R0 + t) * E0P + c) * mix;
                    const float cv = w2 * ext[t + 2] + w1 * ext[t + 1] + w0 * ext[t];
                    const float bo = ld1bf(E0 + (size_t)(R0 + t) * E0P + 1024 + c) * cv;
                    AO[(size_t)(R0 + t) * D + c] = (bf16)f2bf(ao); AO[(size_t)(R0 + t) * D + 512 + c] = (bf16)f2bf(bo);
                }
            }
            __syncthreads();
        }
    }
}

__device__ __forceinline__ void ld8bf(const bf16* p, float (&x)[8]) { const v4u w = *(const v4u*)p;
    x[0] = __uint_as_float(w.x << 16); x[1] = __uint_as_float(w.x & 0xffff0000u); x[2] = __uint_as_float(w.y << 16); x[3] = __uint_as_float(w.y & 0xffff0000u);
    x[4] = __uint_as_float(w.z << 16); x[5] = __uint_as_float(w.z & 0xffff0000u); x[6] = __uint_as_float(w.w << 16); x[7] = __uint_as_float(w.w & 0xffff0000u); }
__device__ __forceinline__ void conv_gate_phase(Frame& F, int layer) {
    const bf16* HU = (const bf16*)(F.ws + WS_HU); bf16* G = (bf16*)(F.ws + WS_G);
    const float* cw = INP(23) + (size_t)layer * 3 * DFF2; const float* cb = INP(24) + (size_t)layer * DFF2;
    const float* st = INP(7) + (size_t)layer * NSQ * 2 * DFF2;
    constexpr int NO = DFF / 8, NCH = M / 32;
    for (int it = F.vcu * NTHR + F.tid; it < NCH * NO; it += F.G * NTHR) {
        const int ch = it / NO, j = (it - ch * NO) * 8, r0 = ch * 32;
        float wa[3][8], wb[3][8], ba[8], bb[8];
#pragma unroll
        for (int k = 0; k < 3; ++k) { const f32x4 a0 = *(const f32x4*)(cw + (size_t)k * DFF2 + j), a1 = *(const f32x4*)(cw + (size_t)k * DFF2 + j + 4), b0 = *(const f32x4*)(cw + (size_t)k * DFF2 + DFF + j), b1 = *(const f32x4*)(cw + (size_t)k * DFF2 + DFF + j + 4);
            wa[k][0] = a0.x; wa[k][1] = a0.y; wa[k][2] = a0.z; wa[k][3] = a0.w; wa[k][4] = a1.x; wa[k][5] = a1.y; wa[k][6] = a1.z; wa[k][7] = a1.w;
            wb[k][0] = b0.x; wb[k][1] = b0.y; wb[k][2] = b0.z; wb[k][3] = b0.w; wb[k][4] = b1.x; wb[k][5] = b1.y; wb[k][6] = b1.z; wb[k][7] = b1.w; }
        { const f32x4 a0 = *(const f32x4*)(cb + j), a1 = *(const f32x4*)(cb + j + 4), b0 = *(const f32x4*)(cb + DFF + j), b1 = *(const f32x4*)(cb + DFF + j + 4);
            ba[0] = a0.x; ba[1] = a0.y; ba[2] = a0.z; ba[3] = a0.w; ba[4] = a1.x; ba[5] = a1.y; ba[6] = a1.z; ba[7] = a1.w; bb[0] = b0.x; bb[1] = b0.y; bb[2] = b0.z; bb[3] = b0.w; bb[4] = b1.x; bb[5] = b1.y; bb[6] = b1.z; bb[7] = b1.w; }
        float a1[8], a2[8], b1[8], b2[8];
        if (r0 < NP && (r0 & (SEQ - 1)) != 0) { ld8bf(HU + (size_t)(r0 - 1) * DFF2 + j, a1); ld8bf(HU + (size_t)(r0 - 1) * DFF2 + DFF + j, b1); ld8bf(HU + (size_t)(r0 - 2) * DFF2 + j, a2); ld8bf(HU + (size_t)(r0 - 2) * DFF2 + DFF + j, b2); }
        else {
#pragma unroll
            for (int e = 0; e < 8; ++e) { a1[e] = 0.f; a2[e] = 0.f; b1[e] = 0.f; b2[e] = 0.f; } }
#pragma unroll 4
        for (int rr = 0; rr < 32; ++rr) {
            const int r = r0 + rr;
            if (r >= NP && ((r - NP) & 3) == 0) {
                const float* s0 = st + (size_t)(((r - NP) >> 2) * 2) * DFF2; const float* s1 = s0 + DFF2;
#pragma unroll
                for (int e = 0; e < 8; ++e) { a2[e] = s0[j + e]; b2[e] = s0[DFF + j + e]; a1[e] = s1[j + e]; b1[e] = s1[DFF + j + e]; }
            }
            float a0[8], b0[8]; ld8bf(HU + (size_t)r * DFF2 + j, a0); ld8bf(HU + (size_t)r * DFF2 + DFF + j, b0);
            float g[8];
#pragma unroll
            for (int e = 0; e < 8; ++e) { const float xa = ba[e] + wa[2][e] * a0[e] + wa[1][e] * a1[e] + wa[0][e] * a2[e], xb = bb[e] + wb[2][e] * b0[e] + wb[1][e] * b1[e] + wb[0][e] * b2[e];
                g[e] = xa * __builtin_amdgcn_rcpf(1.f + __builtin_amdgcn_exp2f(-1.4426950408889634f * xa)) * xb; a2[e] = a1[e]; a1[e] = a0[e]; b2[e] = b1[e]; b1[e] = b0[e]; }
            *(v4u*)(G + (size_t)r * DFF + j) = (v4u){pk2(g[0], g[1]), pk2(g[2], g[3]), pk2(g[4], g[5]), pk2(g[6], g[7])};
        }
    }
}
__device__ __forceinline__ void p10_post_odd(Frame& F) {
    const float* PIN = (const float*)(F.ws + WS_PIN);
    bf16* AO = (bf16*)(F.ws + WS_AO);
    const float* spool = INP(3);
    const int gw = F.vcu * NWAVES + F.wave, NGW = F.G * NWAVES, lane = F.lane;
    for (int r = gw; r < M; r += NGW) {
        const bool smp = r >= NP; const int n = (r - NP) >> 2, tsm = (r - NP) & 3, b = r >> 12, t = r & (SEQ - 1);
        const float* h = PIN + (size_t)r * 512;
        const int g = lane >> 4, w = 2 << g;
        const f32x4 xa = *(const f32x4*)(h + 8 * lane), xc = *(const f32x4*)(h + 8 * lane + 4);
        f32x4 sa = xa, sc = xc; float cnt;
        if (!smp) {
            const int lim = (t + 1 < w) ? t + 1 : w; cnt = (float)lim;
            for (int j = 1; j < lim; ++j) { const float* hj = h - (size_t)j * 512 + 8 * lane; sa += *(const f32x4*)hj; sc += *(const f32x4*)(hj + 4); }
        } else {
            cnt = (float)w;
            for (int j = 1; j < w; ++j) { const int e = 15 + tsm - j;
                const float* hj = (e >= 15) ? PIN + (size_t)(NP + 4 * n + (e - 15)) * 512 + 8 * lane : spool + (size_t)(n * 15 + e) * 512 + 8 * lane;
                sa += *(const f32x4*)hj; sc += *(const f32x4*)(hj + 4); }
        }
        const float ic = 1.f / cnt;
        const f32x4 pa = sa * ic - xa, pc = sc * ic - xc;
        *(v4u*)(AO + (size_t)r * D + 8 * lane) = (v4u){pk2(pa.x, pa.y), pk2(pa.z, pa.w), pk2(pc.x, pc.y), pk2(pc.z, pc.w)};
        if (!smp) { if (t >= SEQ - 15) { float* o = F.out + OUT_CP + (size_t)(b * 15 + (t - (SEQ - 15))) * 512 + 8 * lane; *(f32x4*)o = xa; *(f32x4*)(o + 4) = xc; } }
        else { float* o = F.out + OUT_CS + (size_t)(n * 15 + 11 + tsm) * 512 + 8 * lane; *(f32x4*)o = xa; *(f32x4*)(o + 4) = xc;
            if (tsm == 0) for (int i = 0; i < 11; ++i) { const float* s = spool + (size_t)(n * 15 + 4 + i) * 512 + 8 * lane; float* o2 = F.out + OUT_CS + (size_t)(n * 15 + i) * 512 + 8 * lane;
                *(f32x4*)o2 = *(const f32x4*)s; *(f32x4*)(o2 + 4) = *(const f32x4*)(s + 4); } }
    }
}
__device__ __forceinline__ unsigned sortable(float f) { const unsigned u = __builtin_bit_cast(unsigned, f); return (u & 0x80000000u) ? ~u : (u | 0x80000000u); }
template <int NJ>
__device__ __forceinline__ int count_ge(const unsigned (&key)[NJ], const unsigned cand) {
    unsigned c = 0u;
#pragma unroll
    for (int j = 0; j < NJ; ++j) asm("v_cmp_le_u32_e32 vcc, %2, %1\n\tv_addc_co_u32_e32 %0, vcc, 0, %0, vcc" : "+v"(c) : "v"(key[j]), "s"(cand) : "vcc");
    int tot = 0;
#pragma unroll
    for (int b = 0; b < 7; ++b) tot += __builtin_popcountll(__ballot((c >> b) & 1u)) << b;
    return tot;
}
template <int NJ>
__device__ __forceinline__ void topk_threshold(const unsigned (&key)[NJ], unsigned& T, int& need, bool& exact) {
    T = 0u; exact = false; need = 0;
#pragma unroll 1
    for (int bit = 31; bit >= 0; --bit) {
        const unsigned cand = T | (1u << bit); const int cnt = count_ge<NJ>(key, cand);
        if (cnt >= TOPK) { T = cand; if (cnt == TOPK) { exact = true; return; } }
    }
    int cgt = 0;
#pragma unroll
    for (int j = 0; j < NJ; ++j) cgt += __builtin_popcountll(__ballot(key[j] > T));
    need = TOPK - cgt;
}
template <int NJ>
__device__ __forceinline__ int select_topk(const unsigned (&key)[NJ], int N, int lane, int* sel) {
    const unsigned long long lt = (1ull << lane) - 1ull;
    if (N <= TOPK) { for (int s = lane; s < N; s += 64) sel[s] = s; return N; }
    unsigned T; int need; bool exact; topk_threshold<NJ>(key, T, need, exact);
    int outpos = 0, tseen = 0;
    if (exact) {
#pragma unroll
        for (int j = 0; j < NJ; ++j) { const bool s_ = key[j] >= T; const unsigned long long bs = __ballot(s_); if (s_) sel[outpos + __builtin_popcountll(bs & lt)] = 64 * j + lane; outpos += __builtin_popcountll(bs); }
        return outpos;
    }
#pragma unroll
    for (int j = 0; j < NJ; ++j) {
        const bool gt = key[j] > T, eq = key[j] == T;
        const unsigned long long beq = __ballot(eq);
        const int tr = tseen + __builtin_popcountll(beq & lt);
        const bool s_ = gt || (eq && tr < need);
        const unsigned long long bs = __ballot(s_);
        if (s_) sel[outpos + __builtin_popcountll(bs & lt)] = 64 * j + lane;
        outpos += __builtin_popcountll(bs); tseen += __builtin_popcountll(beq);
    }
    return outpos;
}
template <int NJ>
__device__ __forceinline__ unsigned long long select_mask(const LAS float* srow, int N, int) {
    const int lane = hw_lane();
    const LAS float* sp = srow + lane;
    unsigned key[NJ];
#pragma unroll
    for (int j = 0; j < NJ; ++j) key[j] = (lane < N - 64 * j) ? sortable(sp[64 * j]) : 0u;
    unsigned T; int need; bool exact; topk_threshold<NJ>(key, T, need, exact);
    unsigned mlo = 0u, mhi = 0u;
    if (exact) {
#pragma unroll
        for (int j = 0; j < NJ; ++j) { const unsigned long long bs = __ballot(key[j] >= T); if (lane == j) { mlo = (unsigned)bs; mhi = (unsigned)(bs >> 32); } }
    } else {
        const unsigned long long lt = (1ull << lane) - 1ull; int tseen = 0;
#pragma unroll 1
        for (int j = 0; j < NJ; ++j) {
            unsigned kj = key[0];
#pragma unroll
            for (int jj = 1; jj < NJ; ++jj) kj = (j == jj) ? key[jj] : kj;
            const bool gt = kj > T, eq = kj == T;
            const unsigned long long beq = __ballot(eq);
            const int tr = tseen + __builtin_popcountll(beq & lt);
            const unsigned long long bs = __ballot(gt || (eq && tr < need));
            if (lane == j) { mlo = (unsigned)bs; mhi = (unsigned)(bs >> 32); }
            tseen += __builtin_popcountll(beq);
        }
    }
    return ((unsigned long long)mhi << 32) | mlo;
}
__device__ __forceinline__ void unit_geom(int u, int& b, int& qb, int& R0, int& nkt) { const int w = u & 255, i = u >> 8, j = w >> 2; b = w & 3; qb = (i >> 1) * 128 + ((i & 1) ? 127 - j : j); R0 = b * SEQ + 8 * qb; nkt = (8 * qb + 8 + 15) >> 4; }
constexpr int SPITCH = 4112;
typedef short bf16x8v __attribute__((ext_vector_type(8)));
__device__ __forceinline__ bf16x8v cvt8(const f32x4& a, const f32x4& b) { const v4u w = (v4u){pk2(a.x, a.y), pk2(a.z, a.w), pk2(b.x, b.y), pk2(b.z, b.w)}; return __builtin_bit_cast(bf16x8v, w); }
#define IDX_TILE(A0_, A1_, SC_) do { SC_ = (f32x4){0.f, 0.f, 0.f, 0.f}; \
        _Pragma("unroll") for (int p_ = 0; p_ < 4; ++p_) { \
            f32x4 d_ = __builtin_amdgcn_mfma_f32_16x16x32_bf16(A0_, Bf[p_][0], (f32x4){0.f, 0.f, 0.f, 0.f}, 0, 0, 0); \
            d_ = __builtin_amdgcn_mfma_f32_16x16x32_bf16(A1_, Bf[p_][1], d_, 0, 0, 0); \
            SC_.x += wv[p_] * fmaxf(d_.x, 0.f); SC_.y += wv[p_] * fmaxf(d_.y, 0.f); SC_.z += wv[p_] * fmaxf(d_.z, 0.f); SC_.w += wv[p_] * fmaxf(d_.w, 0.f); } \
        SC_.x += __shfl_xor(SC_.x, 8); SC_.y += __shfl_xor(SC_.y, 8); SC_.z += __shfl_xor(SC_.z, 8); SC_.w += __shfl_xor(SC_.w, 8); } while (0)
__device__ __forceinline__ void p11_indexer(Frame& F, const int flags) {
    const bf16* QIb = (const bf16*)(F.ws + WS_QIB); const bf16* KIb = (const bf16*)(F.ws + WS_KIB); const float* WI = (const float*)(F.ws + WS_WI);
    unsigned long long* MASK = (unsigned long long*)(F.ws + WS_MASK);
    LAS float* S = (LAS float*)F.lds;
    const int lane = F.lane, col = lane & 15, kq = lane >> 4, q = col & 7, hh = col >> 3;
#define UNIT_GEOM(u_, b_, qb_, R0_, nkt_) int b_, qb_, R0_, nkt_; unit_geom((u_), b_, qb_, R0_, nkt_)
#define LDQ(Bf_, wv_, R0_) do { _Pragma("unroll") for (int p_ = 0; p_ < 4; ++p_) { _Pragma("unroll") for (int ks_ = 0; ks_ < 2; ++ks_) Bf_[p_][ks_] = *(const bf16x8v*)(QIb + (size_t)((R0_) + q) * 512 + (2 * p_ + hh) * 64 + 32 * ks_ + 8 * kq); \
        wv_[p_] = WI[(size_t)((R0_) + q) * 8 + 2 * p_ + hh]; } } while (0)
#define LDB(dst, kb_, kt0, nkt_, E0_, E1_) do { _Pragma("unroll") for (int e_ = (E0_); e_ < (E1_); ++e_) { const int kt_ = (kt0) + 8 * e_; if (kt_ < (nkt_)) { const bf16* kp_ = (kb_) + (size_t)kt_ * 1024; dst[e_][0] = *(const bf16x8v*)kp_; dst[e_][1] = *(const bf16x8v*)(kp_ + 32); } } } while (0)
    const int uend = (flags & 1) ? 0 : 2048;
    bf16x8v Bf[4][2]; float wv[4]; bf16x8v Ac[8][2];
    if (F.vcu < uend) { UNIT_GEOM(F.vcu, b0, qb0, R00, nkt0); LDQ(Bf, wv, R00); LDB(Ac, KIb + (size_t)(b0 * SEQ + col) * 64 + 8 * kq, F.wave, nkt0, 0, 4); (void)qb0; }
    for (int u = F.vcu; u < uend; u += F.G) {
        UNIT_GEOM(u, b, qb, R0, nkt);
        const bf16* kbase = KIb + (size_t)(b * SEQ + col) * 64 + 8 * kq;
        LDB(Ac, kbase, F.wave, nkt, 4, 8);
        for (int kt0 = F.wave; kt0 < nkt; kt0 += 64) {
            bf16x8v An[8][2];
            LDB(An, kbase, kt0 + 64, nkt, 0, 8);
#pragma unroll
            for (int e = 0; e < 8; ++e) { const int kt = kt0 + 8 * e;
                if (kt < nkt) { f32x4 sc; IDX_TILE(Ac[e][0], Ac[e][1], sc); if (hh == 0) *(LAS f32x4*)(S + q * SPITCH + 16 * kt + 4 * kq) = sc; } }
#pragma unroll
            for (int e = 0; e < 8; ++e) { Ac[e][0] = An[e][0]; Ac[e][1] = An[e][1]; }
        }
        __syncthreads();
        const int un = u + F.G;
        if (un < uend) { UNIT_GEOM(un, bn, qbn, R0n, nktn); LDQ(Bf, wv, R0n); LDB(Ac, KIb + (size_t)(bn * SEQ + col) * 64 + 8 * kq, F.wave, nktn, 0, 4); (void)qbn; }
        if (!(flags & 4)) {
            const int qq = F.wave, t = 8 * qb + qq, N = t + 1, NJc = (N + 63) >> 6;
            const LAS float* srow = S + qq * SPITCH;
            unsigned long long mine;
            if (N <= TOPK) { const int full = N >> 6; mine = (lane < full) ? ~0ull : (lane == full ? ((1ull << (N & 63)) - 1ull) : 0ull); }
            else if (NJc <= 8) mine = select_mask<8>(srow, N, lane);
            else if (NJc <= 16) mine = select_mask<16>(srow, N, lane);
            else if (NJc <= 24) mine = select_mask<24>(srow, N, lane);
            else if (NJc <= 32) mine = select_mask<32>(srow, N, lane);
            else if (NJc <= 40) mine = select_mask<40>(srow, N, lane);
            else if (NJc <= 48) mine = select_mask<48>(srow, N, lane);
            else if (NJc <= 56) mine = select_mask<56>(srow, N, lane);
            else mine = select_mask<64>(srow, N, lane);
            MASK[(size_t)(R0 + qq) * 64 + lane] = mine;
        }
        __syncthreads();
    }
#undef LDB
#undef LDQ
#undef UNIT_GEOM
    int* SEL = (int*)(F.ws + WS_SEL); int* NSEL = (int*)(F.ws + WS_NSEL);
    const int* ptab = (const int*)INP(8); const float* ckidx = INP(6);
    for (int n = F.vcu; n < ((flags & 2) ? 0 : NSQ); n += F.G) {
        const int R0 = NP + 4 * n, nkt = (PAST + 4 + 15) >> 4;
#pragma unroll
        for (int p = 0; p < 4; ++p) {
#pragma unroll
            for (int ks = 0; ks < 2; ++ks) Bf[p][ks] = *(const bf16x8v*)(QIb + (size_t)(R0 + (q & 3)) * 512 + (2 * p + hh) * 64 + 32 * ks + 8 * kq);
            wv[p] = WI[(size_t)(R0 + (q & 3)) * 8 + 2 * p + hh];
        }
        for (int kt0 = F.wave; kt0 < nkt; kt0 += 64) {
            f32x4 ra[8][4];
#pragma unroll
            for (int e = 0; e < 8; ++e) { const int kt = kt0 + 8 * e;
                if (kt < 128) { const float* kp = ckidx + ((size_t)ptab[n * NPAGES + (kt >> 3)] * PAGE + (kt & 7) * 16 + col) * 64 + 8 * kq;
#pragma unroll
                    for (int x = 0; x < 2; ++x) { ra[e][2 * x] = *(const f32x4*)(kp + 32 * x); ra[e][2 * x + 1] = *(const f32x4*)(kp + 32 * x + 4); } }
                else if (kt == 128) { const float* kp = F.out + OUT_KIS + (size_t)(4 * n + (col < 4 ? col : 3)) * 64 + 8 * kq;
#pragma unroll
                    for (int x = 0; x < 2; ++x) { ra[e][2 * x] = *(const f32x4*)(kp + 32 * x); ra[e][2 * x + 1] = *(const f32x4*)(kp + 32 * x + 4); } } }
#pragma unroll
            for (int e = 0; e < 8; ++e) { const int kt = kt0 + 8 * e;
                if (kt < nkt) { const bf16x8v A0 = cvt8(ra[e][0], ra[e][1]), A1 = cvt8(ra[e][2], ra[e][3]); f32x4 sc; IDX_TILE(A0, A1, sc); if (col < 4) *(LAS f32x4*)(S + q * SPITCH + 16 * kt + 4 * kq) = sc; } }
        }
        __syncthreads();
        if (F.wave < 4) {
            const int qi = F.wave, N = PAST + qi + 1; const int ln = hw_lane(); const LAS float* sp = S + qi * SPITCH + ln;
            unsigned key[33];
#pragma unroll
            for (int jj = 0; jj < 33; ++jj) key[jj] = (ln < N - 64 * jj) ? sortable(sp[64 * jj]) : 0u;
            const int cnt = select_topk<33>(key, N, ln, SEL + (size_t)(R0 + qi) * TOPK);
            if (ln == 0) NSEL[R0 + qi] = cnt;
        }
        __syncthreads();
    }
}
#undef IDX_TILE

__device__ __forceinline__ void p12_attention_sample(Frame& F, LAS unsigned char* lds) {
    const float* QRS = (const float*)(F.ws + WS_QRS); const float* KS = F.out + OUT_KS; const float* VS = F.out + OUT_VS;
    const int* SEL = (const int*)(F.ws + WS_SEL); const int* NSEL = (const int*)(F.ws + WS_NSEL);
    const int* ptab = (const int*)INP(8); const float* ck = INP(4); const float* cv = INP(5);
    bf16* AO = (bf16*)(F.ws + WS_AO);
    LAS float* cmb = (LAS float*)lds;
    const int lane = F.lane;
    for (int pr = F.vcu; pr < NSR / 2; pr += F.G) {
        const int r = NP + 2 * pr + (F.wave >> 2), part = F.wave & 3, n = (r - NP) >> 2;
        const f32x4 qa = *(const f32x4*)(QRS + (size_t)(r - NP) * 512 + 8 * lane) * ATT_SCALE, qc = *(const f32x4*)(QRS + (size_t)(r - NP) * 512 + 8 * lane + 4) * ATT_SCALE;
        const int cnt = NSEL[r]; const int* sel = SEL + (size_t)r * TOPK;
        float mx = -INFINITY, ls = 0.f; f32x4 oa = {0.f, 0.f, 0.f, 0.f}, oc = oa;
#define GATHER(ka_, kc_, va_, vc_, i0_) do { _Pragma("unroll") for (int e_ = 0; e_ < 4; ++e_) { const int i_ = (i0_) + e_; const int s_ = (i_ < cnt) ? sel[i_] : 0; const float* kp_; const float* vp_; \
            if (s_ < PAST) { const size_t ro_ = ((size_t)ptab[n * NPAGES + (s_ >> 7)] * PAGE + (s_ & 127)) * 512; kp_ = ck + ro_; vp_ = cv + ro_; } else { const size_t ro_ = (size_t)(4 * n + (s_ - PAST)) * 512; kp_ = KS + ro_; vp_ = VS + ro_; } \
            ka_[e_] = *(const f32x4*)(kp_ + 8 * lane); kc_[e_] = *(const f32x4*)(kp_ + 8 * lane + 4); va_[e_] = *(const f32x4*)(vp_ + 8 * lane); vc_[e_] = *(const f32x4*)(vp_ + 8 * lane + 4); } } while (0)
        f32x4 ka[4], kc[4], va[4], vc[4];
        GATHER(ka, kc, va, vc, part * 64);
        for (int i0 = part * 64; i0 < part * 64 + 64; i0 += 4) {
            f32x4 ka2[4], kc2[4], va2[4], vc2[4];
            if (i0 + 4 < part * 64 + 64) GATHER(ka2, kc2, va2, vc2, i0 + 4);
#pragma unroll
            for (int e = 0; e < 4; ++e) {
                const f32x4 pr4 = qa * ka[e] + qc * kc[e];
                float lg = (pr4.x + pr4.y) + (pr4.z + pr4.w);
                lg += __shfl_xor(lg, 1); lg += __shfl_xor(lg, 2); lg += __shfl_xor(lg, 4);
                if (i0 + e >= cnt) lg = -INFINITY;
                const float mn = fmaxf(mx, lg);
                if (mn > -INFINITY) { const float sc = __expf(mx - mn), p = __expf(lg - mn); ls = ls * sc + p; oa = oa * sc + va[e] * p; oc = oc * sc + vc[e] * p; mx = mn; }
            }
#pragma unroll
            for (int e = 0; e < 4; ++e) { ka[e] = ka2[e]; kc[e] = kc2[e]; va[e] = va2[e]; vc[e] = vc2[e]; }
        }
#undef GATHER
        LAS float* my = cmb + (F.wave * 64 + lane) * 10;
        my[0] = mx; my[1] = ls; my[2] = oa.x; my[3] = oa.y; my[4] = oa.z; my[5] = oa.w; my[6] = oc.x; my[7] = oc.y; my[8] = oc.z; my[9] = oc.w;
        __syncthreads();
        if (part == 0) {
            float M = -INFINITY;
#pragma unroll
            for (int k = 0; k < 4; ++k) M = fmaxf(M, cmb[((F.wave + k) * 64 + lane) * 10]);
            float L = 0.f, o[8] = {0.f, 0.f, 0.f, 0.f, 0.f, 0.f, 0.f, 0.f};
#pragma unroll
            for (int k = 0; k < 4; ++k) { const LAS float* pk = cmb + ((F.wave + k) * 64 + lane) * 10; const float m = pk[0];
                if (m > -INFINITY) { const float f = __expf(m - M); L += pk[1] * f;
#pragma unroll
                    for (int d = 0; d < 8; ++d) o[d] += pk[2 + d] * f; } }
            const float il = 1.f / L;
            *(v4u*)(AO + (size_t)r * D + 512 + 8 * lane) = (v4u){pk2(o[0] * il, o[1] * il), pk2(o[2] * il, o[3] * il), pk2(o[4] * il, o[5] * il), pk2(o[6] * il, o[7] * il)};
        }
        __syncthreads();
    }
}
#define REFRESH() do { F.lane = hw_lane(); F.tid = F.wave * 64 + F.lane; } while (0)
#define PROBE_FLAGS 0
constexpr int N_PHASES = 19;
struct Args { const float* in[28]; float* out; unsigned char* ws; int ph_lo, ph_hi, flags, pad; };
__global__ void __launch_bounds__(NTHR, 2) fwd(Args args) {
    extern __shared__ __attribute__((aligned(16))) unsigned char lds[];
    Frame F;
    F.lds = (LAS unsigned char*)lds;
    F.MISC = (volatile LAS unsigned*)(F.lds + MISC_OFF);
    F.wave = __builtin_amdgcn_readfirstlane((int)threadIdx.x >> 6); F.lane = hw_lane(); F.tid = F.wave * 64 + F.lane;
    F.G = gridDim.x; { const int bx = blockIdx.x; F.vcu = (F.G % 8 == 0) ? (bx % 8) * (F.G / 8) + bx / 8 : bx; }
    F.out = args.out; F.ws = args.ws;
    F.ctl = (gu32*)(F.ws + WS_CTL);
    for (int u = F.tid; u < (LDS_BYTES - LDSCTL_OFF) / 4; u += NTHR) ((LAS unsigned*)(F.lds + LDSCTL_OFF))[u] = 0u;
    F.itab = (const LAS unsigned long long*)(F.lds + ITAB_OFF);
    if (F.tid < 28) ((LAS unsigned long long*)(F.lds + ITAB_OFF))[F.tid] = (unsigned long long)args.in[F.tid];
    __syncthreads();
    XcdBarrier bar = xcd_barrier_post((unsigned*)(F.ctl + CW_BAR), F.MISC + 8, F.tid == 0);
    const int lo = args.ph_lo, hi = args.ph_hi;
#define IN(k) (lo <= (k) && (k) < hi)
#define SEAM(k) do { if (IN(k) && IN((k) + 1)) { REFRESH(); xcd_barrier(bar, F.tid == 0); } REFRESH(); } while (0)
#ifndef REP_GEMM
#define REP_GEMM 1
#endif
#ifndef REP_DSA
#define REP_DSA 1
#endif
#ifndef REP_ELEM
#define REP_ELEM 1
#endif
#ifndef REP_MIX
#define REP_MIX 1
#endif
#define GEMM(EPI, Aoff, Boff, Nn, Kk, ...) do { GEMM1(EPI, Aoff, Boff, Nn, Kk, __VA_ARGS__); if (REP_GEMM > 1) { REFRESH(); GEMM1(EPI, Aoff, Boff, Nn, Kk, __VA_ARGS__); } } while (0)
#define GEMM1(EPI, Aoff, Boff, Nn, Kk, ...) do { { pg8::Gemm g{(const pg8::bf16_t*)(F.ws + (Aoff)), (const pg8::bf16_t*)(F.ws + (Boff)), M, (Nn), (Kk)}; pg8::StaticOrder S; S.init(M, (Nn), F.G, (int)blockIdx.x); \
        EPI E{__VA_ARGS__}; pg8::gemm_phase<EPI, pg8::StaticOrder, true, true>(F.lds, g, S, E, F.wave); } } while (0)
    float* const Zb = (float*)(F.ws + WS_Y); float* const XF0 = (float*)(F.ws + WS_XF0); float* const XF1 = (float*)(F.ws + WS_XF1);

    if (IN(0)) { p0_prologue(F); } SEAM(0);
    if (IN(1)) { GEMM(EpiInEven, WS_XB0, WS_WINE, ECOLS, D, (bf16*)(F.ws + WS_E0), F.out); } SEAM(1);
    if (IN(2)) { for (int rep_ = 0; rep_ < REP_MIX; ++rep_) p2_mixer_even(F); } SEAM(2);
    if (IN(3)) { const float* xp = INP(0); const float* xs = INP(1); GEMM(EpiRes, WS_AO, WS_WOUTE, D, D, xp, xs, Zb); } SEAM(3);
    if (IN(4)) { for (int rep_ = 0; rep_ < REP_ELEM; ++rep_) ln_phase(F, Zb, INP(20), INP(21), XF0, (bf16*)(F.ws + WS_XBF0)); } SEAM(4);
    if (IN(5)) { GEMM(EpiUp, WS_XBF0, WS_WUP, DFF2, D, (bf16*)(F.ws + WS_HU), F.out, 0); } SEAM(5);
    if (IN(6)) { for (int rep_ = 0; rep_ < REP_ELEM; ++rep_) conv_gate_phase(F, 0); } SEAM(6);
    if (IN(7)) { GEMM(EpiRes, WS_G, WS_WDN, D, DFF, XF0, XF0 + (size_t)NP * D, Zb); } SEAM(7);
    if (IN(8)) { for (int rep_ = 0; rep_ < REP_ELEM; ++rep_) ln_phase(F, Zb, INP(26), INP(27), XF1, (bf16*)(F.ws + WS_XBF1)); } SEAM(8);
    if (IN(9)) { const float* ctab = (const float*)(F.ws + WS_ROPE);
        GEMM(EpiInOdd, WS_XBF1, WS_WINO, OCOLS_P, D, (float*)(F.ws + WS_PIN), (bf16*)(F.ws + WS_QB), (bf16*)(F.ws + WS_KB), (bf16*)(F.ws + WS_VB), (bf16*)(F.ws + WS_QIB), (bf16*)(F.ws + WS_KIB),
             (float*)(F.ws + WS_WI), (float*)(F.ws + WS_QRS), (float*)(F.ws + WS_QIS), F.out, ctab, ctab + 4096 * 8); } SEAM(9);
    if (IN(10)) { for (int rep_ = 0; rep_ < REP_MIX; ++rep_) p10_post_odd(F); } SEAM(10);
    if (IN(11)) { p11_indexer(F, args.flags); } SEAM(11);
    if (IN(12)) {
        const attn_body::AttnTensors AT{(const attn_body::bf16*)(F.ws + WS_QB), (const attn_body::bf16*)(F.ws + WS_KB), (const attn_body::bf16*)(F.ws + WS_VB), (attn_body::bf16*)(F.ws + WS_AO) + 512, (const unsigned long long*)(F.ws + WS_MASK)};
        const attn_body::StaticOrder AS((int)F.G, F.vcu);
        if (!(args.flags & 1)) attn_body::attn_phase<attn_body::StaticOrder>((char*)lds, AT, AS, F.wave);
        REFRESH();
        if (!(args.flags & 2)) p12_attention_sample(F, F.lds + 98304);
    } SEAM(12);
    if (IN(13)) { GEMM(EpiRes, WS_AO, WS_WOUTO, D, D, XF1, XF1 + (size_t)NP * D, Zb); } SEAM(13);
    if (IN(14)) { for (int rep_ = 0; rep_ < REP_ELEM; ++rep_) ln_phase(F, Zb, INP(20) + D, INP(21) + D, XF0, (bf16*)(F.ws + WS_XBF0)); } SEAM(14);
    if (IN(15)) { GEMM(EpiUp, WS_XBF0, WS_WUP + WUP_BYTES, DFF2, D, (bf16*)(F.ws + WS_HU), F.out, 1); } SEAM(15);
    if (IN(16)) { for (int rep_ = 0; rep_ < REP_ELEM; ++rep_) conv_gate_phase(F, 1); } SEAM(16);
    if (IN(17)) { GEMM(EpiRes, WS_G, WS_WDN + WDN_BYTES, D, DFF, XF0, XF0 + (size_t)NP * D, Zb); } SEAM(17);
    if (IN(18)) { for (int rep_ = 0; rep_ < REP_ELEM; ++rep_) ln_phase(F, Zb, INP(26) + D, INP(27) + D, F.out + OUT_YP, (bf16*)nullptr); }
#undef IN
#undef SEAM
}

#ifndef MK_N_LAUNCHES
#define MK_N_LAUNCHES 1
#endif
extern "C" void kernel_launch(void* const* d_in, const int* in_sizes, int n_in, void* d_out, int out_size, void* d_ws, size_t ws_size, hipStream_t stream) {
    static int grid = 0;
    if (grid == 0) {
        if (n_in != 28 || out_size != (int)OUT_END || ws_size < WS_END) { fprintf(stderr, "kernel_launch: unexpected sizes: n_in %d out %d ws %zu\n", n_in, out_size, ws_size); grid = -1; return; }
        int dev = 0, cus = 0, per_cu = 0;
        if (hipGetDevice(&dev) != hipSuccess || hipDeviceGetAttribute(&cus, hipDeviceAttributeMultiprocessorCount, dev) != hipSuccess) { grid = -1; return; }
        if (hipFuncSetAttribute((const void*)fwd, hipFuncAttributeMaxDynamicSharedMemorySize, LDS_BYTES) != hipSuccess) { fprintf(stderr, "kernel_launch: hipFuncSetAttribute failed\n"); grid = -1; return; }
        if (hipOccupancyMaxActiveBlocksPerMultiprocessor(&per_cu, (const void*)fwd, NTHR, LDS_BYTES) != hipSuccess || per_cu < 1) fprintf(stderr, "kernel_launch: occupancy query reports %d\n", per_cu);
        (void)hipGetLastError();
        grid = cus;
    }
    if (grid < 0) return;
    if (hipMemsetAsync((char*)d_ws + WS_CTL, 0, CTL_ZERO_BYTES, stream) != hipSuccess) return;
    Args a{};
    for (int i = 0; i < 28; ++i) a.in[i] = (const float*)d_in[i];
    a.out = (float*)d_out; a.ws = (unsigned char*)d_ws;
#if MK_N_LAUNCHES == 1
    a.ph_lo = 0; a.ph_hi = N_PHASES;
    hipLaunchKernelGGL(fwd, dim3(grid), dim3(NTHR), LDS_BYTES, stream, a);
#ifdef PROBE_PHASES
    { const int pl[] = {PROBE_PHASES}; a.flags = PROBE_FLAGS; for (int p : pl) { a.ph_lo = p; a.ph_hi = p + 1; hipLaunchKernelGGL(fwd, dim3(grid), dim3(NTHR), LDS_BYTES, stream, a); } }
#endif
#else
    for (int p = 0; p < N_PHASES; ++p) { a.ph_lo = p; a.ph_hi = p + 1; hipLaunchKernelGGL(fwd, dim3(grid), dim3(NTHR), LDS_BYTES, stream, a); }
#endif
}
```
